# Optimizing an MI355X kernel written in HIP

```python
import math
import jax, jax.numpy as jnp
from jax import lax
import numpy as np

D_MODEL = 4096
BATCH = 1
SEQ = 8192
DEPTH = 1

CHUNK = 64
Q_BLOCK = 128
ROPE_THETA = 10000.0
EPS = 1e-6
MIX_WIDTH = D_MODEL
MLA_HEADS = 16
MLA_Q_LORA = 768
MLA_KV_LORA = 512
MLA_NOPE = 128
MLA_ROPE = 64
MLA_QK = MLA_NOPE + MLA_ROPE
MLA_V = 128
MLA_SCALE = 1.0 / math.sqrt(MLA_QK)
DIFF_HEADS = 8
DIFF_HEAD_DIM = 128
DIFF_V = 2 * DIFF_HEAD_DIM
DIFF_SCALE = 1.0 / math.sqrt(DIFF_HEAD_DIM)
DIFF_QK_COLS = 2 * DIFF_HEADS * DIFF_HEAD_DIM
DIFF_V_COLS = DIFF_HEADS * DIFF_V
IN_SIZES = (MLA_Q_LORA, MLA_KV_LORA, MLA_ROPE, DIFF_QK_COLS, DIFF_QK_COLS, DIFF_V_COLS)
D_IN = MLA_Q_LORA + MLA_KV_LORA + MLA_ROPE + 2 * DIFF_QK_COLS + DIFF_V_COLS
D_FF = -(-8 * D_MODEL // (3 * 256)) * 256

kernel_name = "hymba_mla_diffattn_swiglu_chunk_causal"


def _rms_norm(t, g):
    tf = t.astype(jnp.float32)
    y = tf * lax.rsqrt(jnp.mean(tf * tf, axis=-1, keepdims=True) + EPS)
    return (y * g.astype(jnp.float32)).astype(t.dtype)


def _rope(t, pos):
    half = t.shape[-1] // 2
    inv_freq = ROPE_THETA ** (-jnp.arange(half, dtype=jnp.float32) / half)
    ang = pos.astype(jnp.float32)[:, None] * inv_freq[None, :]
    cos = jnp.cos(ang)[:, None, :]
    sin = jnp.sin(ang)[:, None, :]
    tf = t.astype(jnp.float32)
    t1, t2 = tf[..., :half], tf[..., half:]
    return jnp.concatenate([t1 * cos - t2 * sin, t2 * cos + t1 * sin], axis=-1).astype(t.dtype)


def _to_blocks(t):
    b, s = t.shape[:2]
    return jnp.moveaxis(t.reshape((b, s // Q_BLOCK, Q_BLOCK) + t.shape[2:]), 1, 0)


def _from_blocks(o):
    o = jnp.moveaxis(o, 0, 1)
    return o.reshape((o.shape[0], o.shape[1] * o.shape[2]) + o.shape[3:])


def _chunk_softmax(s, blk):
    q_pos = blk * Q_BLOCK + jnp.arange(Q_BLOCK)
    k_pos = jnp.arange(s.shape[-1])
    allowed = (k_pos[None, :] // CHUNK) <= (q_pos[:, None] // CHUNK)
    s = jnp.where(allowed, s, jnp.finfo(jnp.float32).min)
    return jax.nn.softmax(s, axis=-1)


def _mla_attend(q, k, v):
    def body(args):
        qb, blk = args
        s = jnp.einsum('bqhd,bkhd->bhqk', qb, k, preferred_element_type=jnp.float32) * MLA_SCALE
        p = _chunk_softmax(s, blk)
        return jnp.einsum('bhqk,bkhd->bqhd', p.astype(v.dtype), v)
    nb = q.shape[1] // Q_BLOCK
    return _from_blocks(lax.map(body, (_to_blocks(q), jnp.arange(nb))))


def _diff_attend(q1, q2, k1, k2, v, lam):
    def body(args):
        qb1, qb2, blk = args
        s1 = jnp.einsum('bqhd,bkhd->bhqk', qb1, k1, preferred_element_type=jnp.float32) * DIFF_SCALE
        s2 = jnp.einsum('bqhd,bkhd->bhqk', qb2, k2, preferred_element_type=jnp.float32) * DIFF_SCALE
        p = _chunk_softmax(s1, blk) - lam * _chunk_softmax(s2, blk)
        return jnp.einsum('bhqk,bkhd->bqhd', p.astype(v.dtype), v)
    nb = q1.shape[1] // Q_BLOCK
    return _from_blocks(lax.map(body, (_to_blocks(q1), _to_blocks(q2), jnp.arange(nb))))


def setup_inputs(seed: int = 0) -> dict:
    key = jax.random.key(seed)
    ks = jax.random.split(key, 22)
    f32 = jnp.float32

    def w(k, fan_in, fan_out):
        return jax.random.normal(k, (DEPTH, fan_in, fan_out), f32) * fan_in ** -0.5

    def gain(k, n):
        return 1.0 + 0.02 * jax.random.normal(k, (DEPTH, n), f32)

    def lam_vec(k):
        return 0.1 * jax.random.normal(k, (DEPTH, DIFF_HEAD_DIM), f32)

    return {
        "x": jax.random.normal(ks[0], (BATCH, SEQ, D_MODEL), f32),
        "attn_norm_g": gain(ks[1], D_MODEL),
        "w_in": w(ks[2], D_MODEL, D_IN),
        "q_latent_norm_g": gain(ks[3], MLA_Q_LORA),
        "kv_latent_norm_g": gain(ks[4], MLA_KV_LORA),
        "w_uq": w(ks[5], MLA_Q_LORA, MLA_HEADS * MLA_QK),
        "w_ukv": w(ks[6], MLA_KV_LORA, MLA_HEADS * (MLA_NOPE + MLA_V)),
        "mla_q_norm_g": gain(ks[7], MLA_QK),
        "mla_k_norm_g": gain(ks[8], MLA_QK),
        "diff_q_norm_g": gain(ks[9], DIFF_HEAD_DIM),
        "diff_k_norm_g": gain(ks[10], DIFF_HEAD_DIM),
        "lambda_q1": lam_vec(ks[11]),
        "lambda_k1": lam_vec(ks[12]),
        "lambda_q2": lam_vec(ks[13]),
        "lambda_k2": lam_vec(ks[14]),
        "diff_subln_g": gain(ks[15], DIFF_V),
        "w_o": w(ks[16], MIX_WIDTH, D_MODEL),
        "ffn_norm_g": gain(ks[17], D_MODEL),
        "w_gate": w(ks[18], D_MODEL, D_FF),
        "w_up": w(ks[19], D_MODEL, D_FF),
        "w_down": w(ks[20], D_FF, D_MODEL),
    }


def reference(x, attn_norm_g, w_in, q_latent_norm_g, kv_latent_norm_g, w_uq, w_ukv,
              mla_q_norm_g, mla_k_norm_g, diff_q_norm_g, diff_k_norm_g,
              lambda_q1, lambda_k1, lambda_q2, lambda_k2, diff_subln_g, w_o,
              ffn_norm_g, w_gate, w_up, w_down):
    b, s, _ = x.shape
    pos = jnp.arange(s)
    split_idx = list(np.cumsum(IN_SIZES)[:-1])
    h = x
    for layer in range(DEPTH):
        lambda_init = 0.8 - 0.6 * math.exp(-0.3 * layer)
        n = _rms_norm(h, attn_norm_g[layer])
        z = n @ w_in[layer]
        c_q, c_kv, k_pe, dq, dk, dv = jnp.split(z, split_idx, axis=-1)

        q = (_rms_norm(c_q, q_latent_norm_g[layer]) @ w_uq[layer]).reshape(b, s, MLA_HEADS, MLA_QK)
        kv = (_rms_norm(c_kv, kv_latent_norm_g[layer]) @ w_ukv[layer]).reshape(b, s, MLA_HEADS, MLA_NOPE + MLA_V)
        k_nope, v_a = kv[..., :MLA_NOPE], kv[..., MLA_NOPE:]
        k_pe = jnp.broadcast_to(k_pe[:, :, None, :], (b, s, MLA_HEADS, MLA_ROPE))
        k = jnp.concatenate([k_nope, k_pe], axis=-1)
        q = _rms_norm(q, mla_q_norm_g[layer])
        k = _rms_norm(k, mla_k_norm_g[layer])
        q = jnp.concatenate([q[..., :MLA_NOPE], _rope(q[..., MLA_NOPE:], pos)], axis=-1)
        k = jnp.concatenate([k[..., :MLA_NOPE], _rope(k[..., MLA_NOPE:], pos)], axis=-1)
        o_a = _mla_attend(q, k, v_a).reshape(b, s, MLA_HEADS * MLA_V)

        dq = _rope(_rms_norm(dq.reshape(b, s, 2 * DIFF_HEADS, DIFF_HEAD_DIM), diff_q_norm_g[layer]), pos)
        dk = _rope(_rms_norm(dk.reshape(b, s, 2 * DIFF_HEADS, DIFF_HEAD_DIM), diff_k_norm_g[layer]), pos)
        dq = dq.reshape(b, s, DIFF_HEADS, 2, DIFF_HEAD_DIM)
        dk = dk.reshape(b, s, DIFF_HEADS, 2, DIFF_HEAD_DIM)
        dv = dv.reshape(b, s, DIFF_HEADS, DIFF_V)
        lam = (jnp.exp(jnp.sum(lambda_q1[layer].astype(jnp.float32) * lambda_k1[layer].astype(jnp.float32)))
               - jnp.exp(jnp.sum(lambda_q2[layer].astype(jnp.float32) * lambda_k2[layer].astype(jnp.float32)))
               + lambda_init)
        o_b = _diff_attend(dq[..., 0, :], dq[..., 1, :], dk[..., 0, :], dk[..., 1, :], dv, lam)
        o_b = (_rms_norm(o_b, diff_subln_g[layer]) * (1.0 - lambda_init)).reshape(b, s, DIFF_HEADS * DIFF_V)

        h = h + jnp.concatenate([o_a, o_b], axis=-1) @ w_o[layer]

        m = _rms_norm(h, ffn_norm_g[layer])
        h = h + (jax.nn.silu(m @ w_gate[layer]) * (m @ w_up[layer])) @ w_down[layer]
    return h
```

```cpp
#include <hip/hip_runtime.h>
#include <hip/hip_cooperative_groups.h>
#include <cstdio>
#include <cstdint>
#include <cmath>
namespace cg = cooperative_groups;
namespace pg8 {
#define PG8_LAS __attribute__((address_space(3)))
typedef unsigned short bf16_t;
typedef short bf16x8 __attribute__((ext_vector_type(8)));
typedef float f32x4 __attribute__((ext_vector_type(4)));
typedef unsigned u32x4 __attribute__((ext_vector_type(4)));
constexpr int BM = 256, BK = 64, HALF = 128, HTB = HALF * BK * 2  , STAGE_BYTES = 8 * HTB, NXCD = 8, WGM = 8;

__host__ __device__ __forceinline__ int lds_byte(int r, int c) { const int st = (r >> 4) * 2 + (c >> 5), rr = r & 15, cc = c & 31, ob = rr * 64 + cc * 2; return st * 1024 + (ob ^ (((ob >> 9) & 1) << 5)); }
__host__ __device__ __forceinline__ void stage_rc(int b, int& R, int& C) { const int st = b / 1024, sb = b % 1024, swz = sb ^ (((sb >> 9) & 1) << 5); R = (st >> 1) * 16 + swz / 64; C = (st & 1) * 32 + (swz % 64) / 2; }
__host__ __device__ __forceinline__ int perm32(int rho) { const int n = rho >> 4, i = rho & 15; return 8 * (i >> 2) + 4 * n + (i & 3); }

struct Unit { int pm, pn; };
struct Gemm { const bf16_t* A; const bf16_t* Bt; int M, N, K; };

struct StaticOrder {
    int nM, nN, nwg, G, c;
    __host__ __device__ void init(int M, int N, int G_, int c_) { nM = M / BM; nN = N / BM; nwg = nM * nN; G = G_; c = c_; }
    __host__ __device__ bool next(int i, Unit& u) const {
        const long L = (long)i * G + c; if (L >= nwg) return false;
        int wgid = (int)L; { const int q = nwg / NXCD, r = nwg % NXCD, xcd = wgid % NXCD, off = wgid / NXCD; wgid = (xcd < r ? xcd * (q + 1) : r * (q + 1) + (xcd - r) * q) + off; }
        const int nig = WGM * nN, gid = wgid / nig, fm = gid * WGM, gsz = (nM - fm) < WGM ? (nM - fm) : WGM;
        u.pm = fm + ((wgid % nig) % gsz); u.pn = (wgid % nig) / gsz; return true;
    }
    __device__ __forceinline__ void a_ready(const Unit&) const {}
    __device__ __forceinline__ void done(const Unit&) const {}
};

__device__ __forceinline__ unsigned cvt_pk_bf16(float lo, float hi) { unsigned r; asm volatile("v_cvt_pk_bf16_f32 %0, %1, %2" : "=v"(r) : "v"(lo), "v"(hi)); return r; }
typedef float f32x2 __attribute__((ext_vector_type(2)));
template <class Epi, class Sched, bool ALIGN_EPI = false, bool SP2 = false>
__device__ __forceinline__ void gemm_phase(PG8_LAS unsigned char* lds, const Gemm g, const Sched& S, const Epi& E, const int tid_in) {
    const int tid = tid_in, wid = __builtin_amdgcn_readfirstlane(tid >> 6), lane = tid & 63, wr = wid >> 2, wc = wid & 3, fr = lane & 15, fq = lane >> 4;
    const int K = g.K, nt = K / BK;
    unsigned voffA[2], voffB[2];
#pragma unroll
    for (int i = 0; i < 2; ++i) { int R, C; stage_rc(tid * 16 + i * 8192, R, C); const int Rb = Epi::PERM ? ((R & ~31) + perm32(R & 31)) : R;
        voffA[i] = (unsigned)(R * K + C) * 2u; voffB[i] = (unsigned)(Rb * K + C) * 2u; }
    const size_t kstep = (size_t)(BK * 2);
    const size_t hstep = (size_t)HALF * K * 2;
    const size_t tstep = 2 * hstep;
    const unsigned ldsw = (unsigned)wid * 1024u;
    const int aoff = lds_byte(wr * 64 + fr, fq * 8), boff = lds_byte(wc * 32 + fr, fq * 8);
#define PG8_SA(b, h) (((b) * 2 + (h)) * HTB)
#define PG8_SB(b, h) ((4 + (b) * 2 + (h)) * HTB)
#define PG8_STAGE(bufoff, gbase, voff) do { _Pragma("unroll") for (int _i = 0; _i < 2; ++_i) \
        __builtin_amdgcn_global_load_lds((const unsigned*)((const char*)(gbase) + (voff)[_i]), (PG8_LAS unsigned*)(lds + (bufoff) + ldsw + _i * 8192), 16, 0, 0); } while (0)
#define PG8_LDA(dst, b, h) do { _Pragma("unroll") for (int m = 0; m < 4; ++m) _Pragma("unroll") for (int k = 0; k < 2; ++k) dst[m][k] = *(const PG8_LAS bf16x8*)(lds + PG8_SA(b, h) + aoff + m * 2048 + k * 1024); } while (0)
#define PG8_LDB(dst, b, h) do { _Pragma("unroll") for (int n = 0; n < 2; ++n) _Pragma("unroll") for (int k = 0; k < 2; ++k) dst[n][k] = *(const PG8_LAS bf16x8*)(lds + PG8_SB(b, h) + boff + n * 2048 + k * 1024); } while (0)
#define PG8_MMA(ai, bj, At, Bt) do { __builtin_amdgcn_s_setprio(1); _Pragma("unroll") for (int m = 0; m < 4; ++m) _Pragma("unroll") for (int n = 0; n < 2; ++n) _Pragma("unroll") for (int k = 0; k < 2; ++k) \
        acc[ai][bj][m][n] = __builtin_amdgcn_mfma_f32_16x16x32_bf16(Bt[n][k], At[m][k], acc[ai][bj][m][n], 0, 0, 0); __builtin_amdgcn_s_setprio(0); } while (0)
#define PG8_WAIT_V(n) asm volatile("s_waitcnt vmcnt(" #n ")" ::: "memory")
#define PG8_WAIT_L(n) asm volatile("s_waitcnt lgkmcnt(" #n ")" ::: "memory")
#define PG8_BAR __builtin_amdgcn_s_barrier()
#define PG8_SCHED __builtin_amdgcn_sched_barrier(0)
    Unit cur, nxt; int ui = 0;
    if (!S.next(0, cur)) return;
    f32x4 acc[2][2][4][2];
#pragma unroll
    for (int a = 0; a < 2; ++a)
#pragma unroll
        for (int b = 0; b < 2; ++b)
#pragma unroll
            for (int m = 0; m < 4; ++m)
#pragma unroll
                for (int n = 0; n < 2; ++n) acc[a][b][m][n] = (f32x4){0.f, 0.f, 0.f, 0.f};
    bf16x8 At[4][2], B0[2][2], B1[2][2];
    const char* cA = (const char*)g.A + (size_t)cur.pm * tstep; const char* cB = (const char*)g.Bt + (size_t)cur.pn * tstep;
    S.a_ready(cur);
    if constexpr (SP2) {
        PG8_STAGE(PG8_SB(0, 0), cB, voffB); PG8_STAGE(PG8_SB(0, 1), cB + hstep, voffB); PG8_STAGE(PG8_SA(0, 0), cA, voffA); PG8_STAGE(PG8_SA(0, 1), cA + hstep, voffA);
        if (wr == 1) PG8_BAR;
        PG8_WAIT_V(2); PG8_BAR;
        PG8_STAGE(PG8_SB(1, 0), cB + kstep, voffB); PG8_STAGE(PG8_SA(1, 0), cA + kstep, voffA); PG8_STAGE(PG8_SB(1, 1), cB + hstep + kstep, voffB);
        PG8_WAIT_V(6); PG8_BAR;
    } else {
        PG8_STAGE(PG8_SB(0, 0), cB, voffB); PG8_STAGE(PG8_SA(0, 0), cA, voffA); PG8_STAGE(PG8_SB(0, 1), cB + hstep, voffB); PG8_STAGE(PG8_SA(0, 1), cA + hstep, voffA);
        if (wr == 1) PG8_BAR;
        PG8_WAIT_V(4); PG8_BAR;
        PG8_STAGE(PG8_SB(1, 0), cB + kstep, voffB); PG8_STAGE(PG8_SA(1, 0), cA + kstep, voffA); PG8_STAGE(PG8_SB(1, 1), cB + hstep + kstep, voffB);
        PG8_WAIT_V(6); PG8_BAR;
    }
    for (;;) {
        const bool has_next = S.next(ui + 1, nxt);
        const char* nA = has_next ? (const char*)g.A + (size_t)nxt.pm * tstep : cA; const char* nB = has_next ? (const char*)g.Bt + (size_t)nxt.pn * tstep : cB;
        for (int t = 0; t < nt; t += 2) {
            const bool last = (t == nt - 2);
            const char* a1 = cA + (size_t)(t + 1) * kstep;
            const char* a2 = last ? nA : cA + (size_t)(t + 2) * kstep; const char* b2 = last ? nB : cB + (size_t)(t + 2) * kstep;
            const char* a3 = a2 + kstep; const char* b3 = b2 + kstep;
            if (last && has_next) S.a_ready(nxt);
            if constexpr (SP2) {
            PG8_LDB(B0, 0, 0); PG8_LDB(B1, 0, 1); PG8_SCHED; PG8_LDA(At, 0, 0); PG8_STAGE(PG8_SA(1, 1), a1 + hstep, voffA);
            PG8_WAIT_V(8); PG8_WAIT_L(0); PG8_BAR; PG8_MMA(0, 0, At, B0); PG8_MMA(0, 1, At, B1); PG8_BAR; PG8_SCHED;
            PG8_LDA(At, 0, 1); PG8_STAGE(PG8_SB(0, 0), b2, voffB); PG8_STAGE(PG8_SB(0, 1), b2 + hstep, voffB); PG8_STAGE(PG8_SA(0, 0), a2, voffA);
            PG8_WAIT_V(8); PG8_WAIT_L(0); PG8_BAR; PG8_MMA(1, 0, At, B0); PG8_MMA(1, 1, At, B1); PG8_BAR; PG8_SCHED;
            PG8_LDB(B0, 1, 0); PG8_LDB(B1, 1, 1); PG8_SCHED; PG8_LDA(At, 1, 0); PG8_STAGE(PG8_SA(0, 1), a2 + hstep, voffA);
            PG8_WAIT_V(8); PG8_WAIT_L(0); PG8_BAR; PG8_MMA(0, 0, At, B0); PG8_MMA(0, 1, At, B1); PG8_BAR; PG8_SCHED;
            PG8_LDA(At, 1, 1); PG8_STAGE(PG8_SB(1, 0), b3, voffB); PG8_STAGE(PG8_SB(1, 1), b3 + hstep, voffB); PG8_STAGE(PG8_SA(1, 0), a3, voffA);
            PG8_WAIT_V(8); PG8_WAIT_L(0); PG8_BAR; PG8_MMA(1, 0, At, B0); PG8_MMA(1, 1, At, B1); PG8_BAR; PG8_SCHED;
            } else {
            PG8_LDB(B0, 0, 0); PG8_SCHED; PG8_LDA(At, 0, 0); PG8_STAGE(PG8_SA(1, 1), a1 + hstep, voffA);
            PG8_WAIT_L(8); PG8_BAR; PG8_WAIT_L(0); PG8_MMA(0, 0, At, B0); PG8_BAR; PG8_SCHED;
            PG8_LDB(B1, 0, 1); PG8_STAGE(PG8_SB(0, 0), b2, voffB);
            PG8_BAR; PG8_WAIT_L(0); PG8_MMA(0, 1, At, B1); PG8_BAR;
            PG8_LDA(At, 0, 1); PG8_STAGE(PG8_SA(0, 0), a2, voffA);
            PG8_BAR; PG8_WAIT_L(0); PG8_MMA(1, 0, At, B0); PG8_BAR; PG8_SCHED;
            PG8_STAGE(PG8_SB(0, 1), b2 + hstep, voffB);
            PG8_WAIT_V(6); PG8_BAR; PG8_MMA(1, 1, At, B1); PG8_BAR;
            PG8_LDB(B0, 1, 0); PG8_SCHED; PG8_LDA(At, 1, 0); PG8_STAGE(PG8_SA(0, 1), a2 + hstep, voffA);
            PG8_WAIT_L(8); PG8_BAR; PG8_WAIT_L(0); PG8_MMA(0, 0, At, B0); PG8_BAR; PG8_SCHED;
            PG8_LDB(B1, 1, 1); PG8_STAGE(PG8_SB(1, 0), b3, voffB);
            PG8_BAR; PG8_WAIT_L(0); PG8_MMA(0, 1, At, B1); PG8_BAR;
            PG8_LDA(At, 1, 1); PG8_STAGE(PG8_SA(1, 0), a3, voffA);
            PG8_BAR; PG8_WAIT_L(0); PG8_MMA(1, 0, At, B0); PG8_BAR; PG8_SCHED;
            PG8_STAGE(PG8_SB(1, 1), b3 + hstep, voffB);
            PG8_WAIT_V(6); PG8_BAR; PG8_MMA(1, 1, At, B1); PG8_BAR;
            }
        }
        if constexpr (ALIGN_EPI) { if (wr == 0) PG8_BAR; }
        if constexpr (!Epi::AFTER_DRAIN) { E(acc, cur, wr, wc, fr, fq); S.done(cur); }
        if (!has_next) break;
#pragma unroll
        for (int a = 0; a < 2; ++a)
#pragma unroll
            for (int b = 0; b < 2; ++b)
#pragma unroll
                for (int m = 0; m < 4; ++m)
#pragma unroll
                    for (int n = 0; n < 2; ++n) acc[a][b][m][n] = (f32x4){0.f, 0.f, 0.f, 0.f};
        cur = nxt; cA = nA; cB = nB; ++ui;
        if constexpr (ALIGN_EPI) { if (wr == 1) PG8_BAR; }
    }
    PG8_WAIT_V(0);
    if constexpr (!ALIGN_EPI) { if (wr == 0) PG8_BAR; }
    PG8_BAR;
    if constexpr (Epi::AFTER_DRAIN) { E.fused(acc, cur, wr, wc, fr, fq, lds, wid, lane); S.done(cur); }
#undef PG8_SA
#undef PG8_SB
#undef PG8_STAGE
#undef PG8_LDA
#undef PG8_LDB
#undef PG8_MMA
#undef PG8_WAIT_V
#undef PG8_WAIT_L
#undef PG8_BAR
#undef PG8_SCHED
}
}

namespace pg8 {
typedef float f32x2e __attribute__((ext_vector_type(2))); typedef __bf16 bf16x2e __attribute__((ext_vector_type(2)));
__device__ __forceinline__ unsigned pk_bf16(float lo, float hi) { f32x2e v = {lo, hi}; bf16x2e b = __builtin_convertvector(v, bf16x2e); return __builtin_bit_cast(unsigned, b); }
struct EpiBf16S {
    static constexpr bool PERM = true, AFTER_DRAIN = false;
    bf16_t* O; int ldc;
    __device__ __forceinline__ void operator()(const f32x4 (&acc)[2][2][4][2], const Unit& u, int wr, int wc, int fr, int fq) const {
        const int row0 = u.pm * BM + wr * 64 + fr, col0 = u.pn * BM + wc * 32 + 8 * fq;
#pragma unroll
        for (int ai = 0; ai < 2; ++ai)
#pragma unroll
            for (int m = 0; m < 4; ++m) { bf16_t* rowp = O + (size_t)(row0 + ai * HALF + m * 16) * ldc + col0;
#pragma unroll
                for (int bj = 0; bj < 2; ++bj) { const f32x4 v0 = acc[ai][bj][m][0], v1 = acc[ai][bj][m][1];
                    u32x4 w; w.x = pk_bf16(v0[0], v0[1]); w.y = pk_bf16(v0[2], v0[3]); w.z = pk_bf16(v1[0], v1[1]); w.w = pk_bf16(v1[2], v1[3]);
                    *(u32x4*)(rowp + bj * HALF) = w; } }
    }
};
struct EpiResF32 {
    static constexpr bool PERM = false, AFTER_DRAIN = false;
    const float* base; float* out; int ldc;
    __device__ __forceinline__ void operator()(const f32x4 (&acc)[2][2][4][2], const Unit& u, int wr, int wc, int fr, int fq) const {
        const int col0 = u.pn * BM + wc * 32 + 4 * fq;
#pragma unroll
        for (int ai = 0; ai < 2; ++ai)
#pragma unroll
            for (int m = 0; m < 4; ++m) { const int r = u.pm * BM + ai * HALF + wr * 64 + m * 16 + fr; const size_t off = (size_t)r * ldc + col0;
#pragma unroll
                for (int bj = 0; bj < 2; ++bj)
#pragma unroll
                    for (int n = 0; n < 2; ++n) { const f32x4 b = *(const f32x4*)(base + off + bj * HALF + n * 16); *(f32x4*)(out + off + bj * HALF + n * 16) = b + acc[ai][bj][m][n]; } }
    }
};
struct EpiHb {
    static constexpr bool PERM = true, AFTER_DRAIN = false;
    const float* base; bf16_t* hb; float* rowss; int ldc;
    __device__ __forceinline__ void operator()(const f32x4 (&acc)[2][2][4][2], const Unit& u, int wr, int wc, int fr, int fq) const {
        const int row0 = u.pm * BM + wr * 64 + fr, col0 = u.pn * BM + wc * 32 + 8 * fq; float ssr[2][4];
#pragma unroll
        for (int ai = 0; ai < 2; ++ai)
#pragma unroll
            for (int m = 0; m < 4; ++m) { const size_t off = (size_t)(row0 + ai * HALF + m * 16) * ldc + col0; float ss = 0.f;
#pragma unroll
                for (int bj = 0; bj < 2; ++bj) { const f32x4 h0 = *(const f32x4*)(base + off + bj * HALF) + acc[ai][bj][m][0], h1 = *(const f32x4*)(base + off + bj * HALF + 4) + acc[ai][bj][m][1];
                    ss += ((h0[0] * h0[0] + h0[1] * h0[1]) + (h0[2] * h0[2] + h0[3] * h0[3])) + ((h1[0] * h1[0] + h1[1] * h1[1]) + (h1[2] * h1[2] + h1[3] * h1[3]));
                    u32x4 w; w.x = pk_bf16(h0[0], h0[1]); w.y = pk_bf16(h0[2], h0[3]); w.z = pk_bf16(h1[0], h1[1]); w.w = pk_bf16(h1[2], h1[3]);
                    *(u32x4*)(hb + off + bj * HALF) = w; }
                ss += __shfl_xor(ss, 16); ss += __shfl_xor(ss, 32); ssr[ai][m] = ss; }
        if (fq == 0) {
#pragma unroll
            for (int ai = 0; ai < 2; ++ai)
#pragma unroll
                for (int m = 0; m < 4; ++m) atomicAdd(rowss + row0 + ai * HALF + m * 16, ssr[ai][m]); }
    }
};
struct EpiOutHb {
    static constexpr bool PERM = false, AFTER_DRAIN = false;
    const bf16_t* hb; float* out; int ldc;
    __device__ __forceinline__ void operator()(const f32x4 (&acc)[2][2][4][2], const Unit& u, int wr, int wc, int fr, int fq) const {
        typedef unsigned u32x2e __attribute__((ext_vector_type(2)));
        const int col0 = u.pn * BM + wc * 32 + 4 * fq;
#pragma unroll
        for (int ai = 0; ai < 2; ++ai)
#pragma unroll
            for (int m = 0; m < 4; ++m) { const int r = u.pm * BM + ai * HALF + wr * 64 + m * 16 + fr; const size_t off = (size_t)r * ldc + col0;
#pragma unroll
                for (int bj = 0; bj < 2; ++bj)
#pragma unroll
                    for (int n = 0; n < 2; ++n) { const u32x2e w = *(const u32x2e*)(hb + off + bj * HALF + n * 16);
                        const f32x4 b = {__uint_as_float(w.x << 16), __uint_as_float(w.x & 0xffff0000u), __uint_as_float(w.y << 16), __uint_as_float(w.y & 0xffff0000u)};
                        *(f32x4*)(out + off + bj * HALF + n * 16) = b + acc[ai][bj][m][n]; } }
    }
};
struct EpiSwiGLU {
    static constexpr bool PERM = true, AFTER_DRAIN = false;
    bf16_t* O; int ldc; const float* rowss; float invk, eps;
    __device__ __forceinline__ static float act(float g, float u) { return g * u * __builtin_amdgcn_rcpf(1.0f + __builtin_amdgcn_exp2f(-1.4426950408889634f * g)); }
    __device__ __forceinline__ void operator()(const f32x4 (&acc)[2][2][4][2], const Unit& u, int wr, int wc, int fr, int fq) const {
        const int row0 = u.pm * BM + wr * 64 + fr, col0 = u.pn * HALF + wc * 32 + 8 * fq;
        float rs[2][4];
#pragma unroll
        for (int ai = 0; ai < 2; ++ai)
#pragma unroll
            for (int m = 0; m < 4; ++m) rs[ai][m] = rowss[row0 + ai * HALF + m * 16];
#pragma unroll
        for (int ai = 0; ai < 2; ++ai)
#pragma unroll
            for (int m = 0; m < 4; ++m) { bf16_t* rowp = O + (size_t)(row0 + ai * HALF + m * 16) * ldc + col0;
                const float r1 = 1.0f / sqrtf(rs[ai][m] * invk + eps);
                const f32x4 g0 = acc[ai][0][m][0] * r1, g1 = acc[ai][0][m][1] * r1, u0 = acc[ai][1][m][0] * r1, u1 = acc[ai][1][m][1] * r1;
                u32x4 w; w.x = pk_bf16(act(g0[0], u0[0]), act(g0[1], u0[1])); w.y = pk_bf16(act(g0[2], u0[2]), act(g0[3], u0[3]));
                w.z = pk_bf16(act(g1[0], u1[0]), act(g1[1], u1[1])); w.w = pk_bf16(act(g1[2], u1[2]), act(g1[3], u1[3]));
                *(u32x4*)(rowp) = w; }
    }
};
}

#define GAS __attribute__((address_space(1)))
#define LAS __attribute__((address_space(3)))
typedef unsigned short bf16;
typedef unsigned u32x4 __attribute__((ext_vector_type(4)));
typedef unsigned u32x2 __attribute__((ext_vector_type(2)));
typedef float f32x4 __attribute__((ext_vector_type(4)));
typedef short bf16x8 __attribute__((ext_vector_type(8)));
typedef float f32x16 __attribute__((ext_vector_type(16)));
constexpr int SEQ = 8192, DM = 4096, DIN = 7488, ZLD = 7680, DFF = 11008;
constexpr int C_CKV = 768, C_KPE = 1280, C_DQ = 1344, C_DK = 3392, C_DV = 5440;
constexpr float EPS = 1e-6f, LOG2E = 1.4426950408889634f;
constexpr float QSC_MLA = 0.07216878364870323f * LOG2E;
constexpr float QSC_DIFF = 0.08838834764831845f * LOG2E;
constexpr float LAMBDA_INIT = 0.2f;
constexpr int NWAVES = 8;
constexpr int LDS_BYTES = 147456;

constexpr size_t WS_BAR = 0;
constexpr size_t WS_WIN = 16384;
constexpr size_t WS_WUQ = WS_WIN + (size_t)ZLD * DM * 2;
constexpr size_t WS_WUKV = WS_WUQ + (size_t)3072 * 768 * 2;
constexpr size_t WS_WO = WS_WUKV + (size_t)4096 * 512 * 2;
constexpr size_t WS_WGU = WS_WO + (size_t)DM * DM * 2;
constexpr size_t WS_WDN = WS_WGU + (size_t)2 * DFF * DM * 2;
constexpr size_t WS_XN = WS_WDN + (size_t)DM * DFF * 2;
constexpr size_t WS_R1 = WS_XN + (size_t)SEQ * DM * 2;
constexpr size_t WS_Z = WS_R1;
constexpr size_t WS_CQN = WS_Z + (size_t)SEQ * ZLD * 2;
constexpr size_t WS_CKVN = WS_CQN + (size_t)SEQ * 768 * 2;
constexpr size_t WS_QRAW = WS_CKVN + (size_t)SEQ * 512 * 2;
constexpr size_t WS_KVRAW = WS_QRAW + (size_t)SEQ * 3072 * 2;
constexpr size_t WS_R1END = WS_KVRAW + (size_t)SEQ * 4096 * 2;
constexpr size_t WS_QA = WS_R1;
constexpr size_t WS_KA = WS_QA + (size_t)SEQ * 3072 * 2;
constexpr size_t WS_VAT = WS_KA + (size_t)SEQ * 3072 * 2;
static_assert(WS_VAT + (size_t)SEQ * 2048 * 2 <= WS_QRAW, "QA|KA|VAT overlay z|cqn|ckvn only");
constexpr size_t WS_OC = WS_QRAW;
constexpr size_t WS_ACT = WS_R1;
static_assert(WS_ACT + (size_t)SEQ * DFF * 2 <= WS_R1END, "act inside R1");
constexpr size_t WS_QD = WS_R1END;
constexpr size_t WS_KD = WS_QD + (size_t)SEQ * 2048 * 2;
constexpr size_t WS_VDT = WS_KD + (size_t)SEQ * 2048 * 2;
constexpr size_t WS_KPE = WS_VDT + (size_t)SEQ * 2048 * 2;
constexpr size_t WS_ROWSS = WS_KPE + (size_t)SEQ * 64 * 2;
constexpr size_t WS_END = WS_ROWSS + (size_t)SEQ * 4;

struct Args { const float* in[21]; float* out; unsigned char* ws; float invf[64]; int ph_lo, ph_hi; };
static_assert(sizeof(Args) == 21 * 8 + 8 + 8 + 256 + 8, "Args has no padding");

__device__ __forceinline__ float wave_sum(float v) {
#pragma unroll
    for (int o = 1; o < 64; o <<= 1) v += __shfl_xor(v, o);
    return v;
}
__device__ __forceinline__ float bflo(unsigned w) { return __uint_as_float(w << 16); }
__device__ __forceinline__ float bfhi(unsigned w) { return __uint_as_float(w & 0xffff0000u); }
__device__ __forceinline__ void unpack8(const u32x4 a, float (&v)[8]) {
    v[0] = bflo(a.x); v[1] = bfhi(a.x); v[2] = bflo(a.y); v[3] = bfhi(a.y); v[4] = bflo(a.z); v[5] = bfhi(a.z); v[6] = bflo(a.w); v[7] = bfhi(a.w);
}
__device__ __forceinline__ u32x4 pack8(const float (&v)[8]) {
    u32x4 w; w.x = pg8::pk_bf16(v[0], v[1]); w.y = pg8::pk_bf16(v[2], v[3]); w.z = pg8::pk_bf16(v[4], v[5]); w.w = pg8::pk_bf16(v[6], v[7]); return w;
}
__device__ __forceinline__ u32x4 ld16(const bf16* p) { return *(const u32x4*)p; }
__device__ __forceinline__ void st16(bf16* p, u32x4 v) { *(u32x4*)p = v; }
__device__ __forceinline__ void ldg8(const float* g, float (&v)[8]) { const f32x4 a = *(const f32x4*)g, b = *(const f32x4*)(g + 4); v[0] = a.x; v[1] = a.y; v[2] = a.z; v[3] = a.w; v[4] = b.x; v[5] = b.y; v[6] = b.z; v[7] = b.w; }
__device__ __forceinline__ void rope_cs(int pos, float invf, float& c, float& s) {
    const float ang = (float)pos * invf; const double rev = (double)ang * 0.15915494309189535; const float fr = (float)(rev - __builtin_rint(rev));
    c = __builtin_amdgcn_cosf(fr); s = __builtin_amdgcn_sinf(fr);
}

__device__ __forceinline__ void p0_transpose_item(const float* W, int K, int N, bf16* WT, int mode, LAS float* scr, int item, int lane) {
    const int nblk = N / 32, kb = item / nblk, nb = item % nblk, k0 = 64 * kb, n0 = 32 * nb;
    {
        f32x4 t[8]; const int kq = lane >> 3, n4 = (lane & 7) * 4;
#pragma unroll
        for (int i = 0; i < 8; ++i) t[i] = *(const f32x4*)(W + (size_t)(k0 + kq + 8 * i) * N + n0 + n4);
#pragma unroll
        for (int i = 0; i < 8; ++i) { LAS float* d = scr + (kq + 8 * i) * 33 + n4; d[0] = t[i].x; d[1] = t[i].y; d[2] = t[i].z; d[3] = t[i].w; }
    }
    asm volatile("s_waitcnt lgkmcnt(0)" ::: "memory");
    const int c = lane & 7;
    const int rbase = (mode == 0) ? n0 : (((n0 >> 7) << 8) + (n0 & 127) + (mode == 2 ? 128 : 0));
#pragma unroll
    for (int j = 0; j < 4; ++j) { const int n = (lane >> 3) + 8 * j; const LAS float* s = scr + (8 * c) * 33 + n;
        u32x4 o; o.x = pg8::pk_bf16(s[0 * 33], s[1 * 33]); o.y = pg8::pk_bf16(s[2 * 33], s[3 * 33]); o.z = pg8::pk_bf16(s[4 * 33], s[5 * 33]); o.w = pg8::pk_bf16(s[6 * 33], s[7 * 33]);
        *(u32x4*)(WT + (size_t)(rbase + n) * K + k0 + 8 * c) = o; }
    asm volatile("s_waitcnt lgkmcnt(0)" ::: "memory");
}
struct ItemRegs { f32x4 t[8]; };
__device__ __forceinline__ void item_load(ItemRegs& R, const float* W, int N, int item, int lane, const float* gk = nullptr) {
    const int nblk = N / 32, kb = item / nblk, nb = item % nblk, k0 = 64 * kb, n0 = 32 * nb, kq = lane >> 3, n4 = (lane & 7) * 4;
#pragma unroll
    for (int i = 0; i < 8; ++i) { R.t[i] = *(const f32x4*)(W + (size_t)(k0 + kq + 8 * i) * N + n0 + n4); if (gk) R.t[i] = R.t[i] * gk[k0 + kq + 8 * i]; }
}
__device__ __forceinline__ void item_store(const ItemRegs& R, int K, int N, bf16* WT, int mode, LAS float* scr, int item, int lane) {
    const int nblk = N / 32, kb = item / nblk, nb = item % nblk, k0 = 64 * kb, n0 = 32 * nb, kq = lane >> 3, n4 = (lane & 7) * 4;
#pragma unroll
    for (int i = 0; i < 8; ++i) { LAS float* d = scr + (kq + 8 * i) * 33 + n4; d[0] = R.t[i].x; d[1] = R.t[i].y; d[2] = R.t[i].z; d[3] = R.t[i].w; }
    asm volatile("s_waitcnt lgkmcnt(0)" ::: "memory");
    const int c = lane & 7;
    const int rbase = (mode == 0) ? n0 : (((n0 >> 7) << 8) + (n0 & 127) + (mode == 2 ? 128 : 0));
#pragma unroll
    for (int j = 0; j < 4; ++j) { const int n = (lane >> 3) + 8 * j; const LAS float* s = scr + (8 * c) * 33 + n;
        u32x4 o; o.x = pg8::pk_bf16(s[0 * 33], s[1 * 33]); o.y = pg8::pk_bf16(s[2 * 33], s[3 * 33]); o.z = pg8::pk_bf16(s[4 * 33], s[5 * 33]); o.w = pg8::pk_bf16(s[6 * 33], s[7 * 33]);
        *(u32x4*)(WT + (size_t)(rbase + n) * K + k0 + 8 * c) = o; }
    asm volatile("s_waitcnt lgkmcnt(0)" ::: "memory");
}
__device__ __forceinline__ void conv_stream(const float* W, int K, int N, bf16* WT, int mode, LAS float* scr, int begin, int end, int stride, int lane, const float* gk = nullptr) {
    if (begin >= end) return;
    ItemRegs r0, r1, r2; item_load(r0, W, N, begin, lane, gk); if (begin + stride < end) item_load(r1, W, N, begin + stride, lane, gk);
    for (int it = begin; it < end; it += stride) { const int it2 = it + 2 * stride; if (it2 < end) item_load(r2, W, N, it2, lane, gk); item_store(r0, K, N, WT, mode, scr, it, lane); r0 = r1; r1 = r2; }
}
__device__ __forceinline__ void rms_row_4096(const float* xrow, const float* g, bf16* orow, int lane) {
    const f32x4* xr = (const f32x4*)xrow + lane; f32x4 v[16]; float s = 0.f;
#pragma unroll
    for (int j = 0; j < 16; ++j) { v[j] = xr[64 * j]; s += (v[j].x * v[j].x + v[j].y * v[j].y) + (v[j].z * v[j].z + v[j].w * v[j].w); }
    const float rstd = 1.0f / sqrtf(wave_sum(s) * (1.f / 4096.f) + EPS);
    const f32x4* gr = (const f32x4*)g + lane; u32x2* o8 = (u32x2*)orow + lane;
#pragma unroll
    for (int j = 0; j < 16; ++j) { const f32x4 gg = gr[64 * j]; u32x2 w; w.x = pg8::pk_bf16(v[j].x * rstd * gg.x, v[j].y * rstd * gg.y); w.y = pg8::pk_bf16(v[j].z * rstd * gg.z, v[j].w * rstd * gg.w); o8[64 * j] = w; }
}
#define RLX_AGENT __ATOMIC_RELAXED, __HIP_MEMORY_SCOPE_AGENT
#define XB_TMO      128
#define XB_XCNT(j)  (256  + 64 * (j))
#define XB_XSUB(j)  (1280 + 64 * (j))
#define XB_XGEN(j)  (2304 + 64 * (j))
#define XB_TOP      3328
#define XB_TOPGEN   3392
#define XCD_BAR_WORDS 3456
#define XB_SPIN_CAP (1u << 18)

__device__ __forceinline__ unsigned xb_ld(unsigned* p)              { return __hip_atomic_load(p, __ATOMIC_RELAXED, __HIP_MEMORY_SCOPE_AGENT); }
__device__ __forceinline__ unsigned xb_add(unsigned* p, unsigned v) { return __hip_atomic_fetch_add(p, v, __ATOMIC_RELAXED, __HIP_MEMORY_SCOPE_AGENT); }
__device__ __forceinline__ unsigned xb_xcc_id() { return (unsigned)__builtin_amdgcn_s_getreg((3 << 11) | 20) & 0xFu; }
#define XB_SPIN(cond, bar) do { unsigned _sp = 0; while (cond) { __builtin_amdgcn_s_sleep(1); \
    if ((++_sp & 255u) == 0u) { if (xb_ld(&(bar)[XB_TMO])) break; if (_sp > XB_SPIN_CAP) { atomicAdd(&(bar)[XB_TMO], 1u); break; } } } } while (0)

struct XcdBarrier {
    unsigned* bar; unsigned x;
    volatile LAS unsigned* st;
};

__device__ __forceinline__ XcdBarrier xcd_barrier_post(unsigned* bar, volatile LAS unsigned* st, bool t0) {
    XcdBarrier b; b.bar = bar; b.x = xb_xcc_id(); b.st = st;
    if (t0) (void)xb_add(&bar[XB_XCNT(b.x)], 1u);
    return b;
}
__device__ __forceinline__ void xcd_barrier_complete(unsigned* bar, unsigned x, unsigned& nloc, unsigned& nx) {
    const unsigned G = gridDim.x * gridDim.y * gridDim.z;
    unsigned sum, cnt, mine, sp = 0u;
    for (;;) {
        sum = 0u; cnt = 0u; mine = 0u;
#pragma unroll
        for (unsigned j = 0; j < 16; ++j) { const unsigned c = xb_ld(&bar[XB_XCNT(j)]); sum += c; cnt += (c > 0u) ? 1u : 0u; mine = (j == x) ? c : mine; }
        if (sum == G) break;
        __builtin_amdgcn_s_sleep(1);
        if ((++sp & 255u) == 0u) { if (xb_ld(&bar[XB_TMO])) break; if (sp > XB_SPIN_CAP) { atomicAdd(&bar[XB_TMO], 1u); break; } }
    }
    nloc = mine > 0u ? mine : 1u; nx = cnt > 0u ? cnt : 1u;
}

__device__ __forceinline__ void xcd_barrier(const XcdBarrier& b, bool t0) {
    asm volatile("s_waitcnt vmcnt(0)" ::: "memory");
    __syncthreads();
    if (t0) {
        unsigned* bar = b.bar;
        __builtin_amdgcn_s_waitcnt(0);
        unsigned nloc = b.st[0], nx = b.st[1];
        if (nloc == 0u) { xcd_barrier_complete(bar, b.x, nloc, nx); b.st[0] = nloc; b.st[1] = nx; }
        const unsigned old = xb_add(&bar[XB_XSUB(b.x)], 1u);
        const unsigned gen = old / nloc;
        if (old + 1u == (gen + 1u) * nloc) {
            __builtin_amdgcn_fence(__ATOMIC_RELEASE, "agent");
            asm volatile("s_waitcnt vmcnt(0)" ::: "memory");
            const unsigned og = xb_add(&bar[XB_TOP], 1u);
            const unsigned tg = og / nx;
            if (og + 1u == (tg + 1u) * nx) xb_add(&bar[XB_TOPGEN], 1u);
            else XB_SPIN(xb_ld(&bar[XB_TOPGEN]) == tg, bar);
            __builtin_amdgcn_fence(__ATOMIC_ACQUIRE, "agent");
            xb_add(&bar[XB_XGEN(b.x)], 1u);
            asm volatile("s_waitcnt vmcnt(0)" ::: "memory");
        } else {
            XB_SPIN(xb_ld(&bar[XB_XGEN(b.x)]) == gen, bar);
            __builtin_amdgcn_fence(__ATOMIC_ACQUIRE, "agent");
            asm volatile("s_waitcnt vmcnt(0)" ::: "memory");
        }
    }
    __syncthreads();
}

constexpr int TP_PITCH = 1040;
__device__ __forceinline__ void tp_store(LAS const unsigned char* tl, bf16* dst, int s0, int tid) {
#pragma unroll
    for (int k = 0; k < 4; ++k) { const int idx = tid + 512 * k, sg = idx & 3, col = idx >> 2; const LAS unsigned char* p = tl + (8 * sg) * TP_PITCH + 2 * col;
        unsigned short e[8];
#pragma unroll
        for (int i = 0; i < 8; ++i) e[i] = *(const LAS unsigned short*)(p + i * TP_PITCH);
        u32x4 w; w.x = e[0] | ((unsigned)e[1] << 16); w.y = e[2] | ((unsigned)e[3] << 16); w.z = e[4] | ((unsigned)e[5] << 16); w.w = e[6] | ((unsigned)e[7] << 16);
        st16(dst + (size_t)col * SEQ + s0 + 8 * sg, w); }
}

struct P2Row { u32x4 cq0, cq1, ckv, kpe, dq[4], dk[4]; };
__device__ __forceinline__ void p2_load(P2Row& R, const bf16* zr, int lane) {
    const u32x4 z4 = {0u, 0u, 0u, 0u}; const int sub = lane & 15;
    R.cq0 = ld16(zr + 8 * lane); R.cq1 = (lane < 32) ? ld16(zr + 512 + 8 * lane) : z4; R.ckv = ld16(zr + C_CKV + 8 * lane); R.kpe = (lane < 8) ? ld16(zr + C_KPE + 8 * lane) : z4;
#pragma unroll
    for (int rd = 0; rd < 4; ++rd) { const int head = rd * 4 + (lane >> 4); R.dq[rd] = ld16(zr + C_DQ + head * 128 + sub * 8); R.dk[rd] = ld16(zr + C_DK + head * 128 + sub * 8); }
}
__device__ __forceinline__ void p2_phase(const Args& A, LAS unsigned char* lds, int vcu, int G, int tid, int wave, int lane) {
    unsigned char* ws = A.ws;
    const bf16* Z = (const bf16*)(ws + WS_Z); bf16* CQN = (bf16*)(ws + WS_CQN); bf16* CKVN = (bf16*)(ws + WS_CKVN); bf16* KPE = (bf16*)(ws + WS_KPE);
    bf16* QD = (bf16*)(ws + WS_QD); bf16* KD = (bf16*)(ws + WS_KD); bf16* VDT = (bf16*)(ws + WS_VDT);
    const int sub = lane & 15;
    float gq0[8], gq1[8], gkv[8], gdq[8], gdk[8];
    ldg8(A.in[3] + 8 * lane, gq0); ldg8(A.in[3] + 512 + 8 * (lane & 31), gq1); ldg8(A.in[4] + 8 * lane, gkv); ldg8(A.in[9] + 8 * sub, gdq); ldg8(A.in[10] + 8 * sub, gdk);
    float ifr[8];
#pragma unroll
    for (int e = 0; e < 8; ++e) ifr[e] = A.invf[8 * (sub & 7) + e];
    for (int unit = vcu; unit < SEQ / 32; unit += G) {
        const int s0 = unit * 32;
        P2Row cur, nxt;
        p2_load(cur, Z + (size_t)(s0 + wave * 4) * ZLD, lane);
#pragma unroll
        for (int i = 0; i < 4; ++i) {
            const int row = s0 + wave * 4 + i;
            if (i < 3) p2_load(nxt, Z + (size_t)(row + 1) * ZLD, lane);
            {
                float va[8], vb[8]; unpack8(cur.cq0, va); unpack8(cur.cq1, vb); float ss = 0.f;
#pragma unroll
                for (int e = 0; e < 8; ++e) ss += va[e] * va[e] + vb[e] * vb[e];
                const float rstd = 1.0f / sqrtf(wave_sum(ss) * (1.f / 768.f) + EPS);
#pragma unroll
                for (int e = 0; e < 8; ++e) { va[e] = va[e] * rstd * gq0[e]; vb[e] = vb[e] * rstd * gq1[e]; }
                st16(CQN + (size_t)row * 768 + 8 * lane, pack8(va));
                if (lane < 32) st16(CQN + (size_t)row * 768 + 512 + 8 * lane, pack8(vb));
            }
            {
                float va[8]; unpack8(cur.ckv, va); float ss = 0.f;
#pragma unroll
                for (int e = 0; e < 8; ++e) ss += va[e] * va[e];
                const float rstd = 1.0f / sqrtf(wave_sum(ss) * (1.f / 512.f) + EPS);
#pragma unroll
                for (int e = 0; e < 8; ++e) va[e] = va[e] * rstd * gkv[e];
                st16(CKVN + (size_t)row * 512 + 8 * lane, pack8(va));
            }
            if (lane < 8) st16(KPE + (size_t)row * 64 + 8 * lane, cur.kpe);
            float cs[8], sn[8];
#pragma unroll
            for (int e = 0; e < 8; ++e) rope_cs(row, ifr[e], cs[e], sn[e]);
#pragma unroll
            for (int which = 0; which < 2; ++which) {
                bf16* dst = which ? KD : QD; const float osc = which ? 1.0f : QSC_DIFF;
#pragma unroll
                for (int rd = 0; rd < 4; ++rd) {
                    const int head = rd * 4 + (lane >> 4);
                    float v[8]; unpack8(which ? cur.dk[rd] : cur.dq[rd], v); float ss = 0.f;
#pragma unroll
                    for (int e = 0; e < 8; ++e) ss += v[e] * v[e];
                    ss += __shfl_xor(ss, 1); ss += __shfl_xor(ss, 2); ss += __shfl_xor(ss, 4); ss += __shfl_xor(ss, 8);
                    const float rstd = 1.0f / sqrtf(ss * (1.f / 128.f) + EPS);
                    float o[8];
#pragma unroll
                    for (int e = 0; e < 8; ++e) { const float y = v[e] * rstd * (which ? gdk[e] : gdq[e]); const float p = __shfl_xor(y, 8); o[e] = ((sub < 8) ? (y * cs[e] - p * sn[e]) : (y * cs[e] + p * sn[e])) * osc; }
                    st16(dst + (size_t)row * 2048 + head * 128 + sub * 8, pack8(o));
                }
            }
            cur = nxt;
        }
        for (int pass = 0; pass < 4; ++pass) {
            __syncthreads();
#pragma unroll
            for (int k = 0; k < 4; ++k) { const int idx = tid + 512 * k, r = idx >> 6, c = idx & 63;
                *(LAS u32x4*)(lds + r * TP_PITCH + 16 * c) = ld16(Z + (size_t)(s0 + r) * ZLD + C_DV + 512 * pass + 8 * c); }
            __syncthreads();
            tp_store(lds, VDT + (size_t)(512 * pass) * SEQ, s0, tid);
        }
        __syncthreads();
    }
}

struct P4Row { u32x4 q[8], k[8]; };
__device__ __forceinline__ void p4_load(P4Row& R, const bf16* QRAW, const bf16* KVRAW, const bf16* KPE, int row, int lane) {
    const u32x4 z4 = {0u, 0u, 0u, 0u}; const int sub = lane & 31, hsel = lane >> 5; const bool act = sub < 24;
    const u32x4 kpe = (sub >= 16 && act) ? ld16(KPE + (size_t)row * 64 + (sub - 16) * 8) : z4;
#pragma unroll
    for (int rd = 0; rd < 8; ++rd) { const int head = 2 * rd + hsel;
        R.q[rd] = act ? ld16(QRAW + (size_t)row * 3072 + head * 192 + sub * 8) : z4;
        R.k[rd] = (sub < 16) ? ld16(KVRAW + (size_t)row * 4096 + head * 256 + sub * 8) : kpe; }
}
__device__ __forceinline__ void p4_phase(const Args& A, LAS unsigned char* lds, int vcu, int G, int tid, int wave, int lane) {
    unsigned char* ws = A.ws;
    const bf16* QRAW = (const bf16*)(ws + WS_QRAW); const bf16* KVRAW = (const bf16*)(ws + WS_KVRAW); const bf16* KPE = (const bf16*)(ws + WS_KPE);
    bf16* QA = (bf16*)(ws + WS_QA); bf16* KA = (bf16*)(ws + WS_KA); bf16* VAT = (bf16*)(ws + WS_VAT);
    const int sub = lane & 31, hsel = lane >> 5; const bool act = sub < 24; const int subc = act ? sub : 0;
    const bool rlo = (sub >= 16 && sub < 20), rhi = (sub >= 20 && sub < 24);
    float gq[8], gk[8]; ldg8(A.in[7] + 8 * subc, gq); ldg8(A.in[8] + 8 * subc, gk);
    float ifr[8];
#pragma unroll
    for (int e = 0; e < 8; ++e) ifr[e] = A.invf[2 * (8 * (sub & 3) + e)];
    for (int unit = vcu; unit < SEQ / 32; unit += G) {
        const int s0 = unit * 32;
        for (int i = 0; i < 4; ++i) {
            const int row = s0 + wave * 4 + i;
            P4Row cur; { int lo_ = lane; asm volatile("" : "+v"(lo_)); p4_load(cur, QRAW, KVRAW, KPE, row, lo_); }
            float cs[8], sn[8];
#pragma unroll
            for (int e = 0; e < 8; ++e) rope_cs(row, ifr[e], cs[e], sn[e]);
#pragma unroll
            for (int which = 0; which < 2; ++which) {
                bf16* dst = which ? KA : QA; const float osc = which ? 1.0f : QSC_MLA;
#pragma unroll
                for (int rd = 0; rd < 8; ++rd) {
                    const int head = 2 * rd + hsel;
                    float v[8]; unpack8(which ? cur.k[rd] : cur.q[rd], v); float ss = 0.f;
#pragma unroll
                    for (int e = 0; e < 8; ++e) ss += v[e] * v[e];
                    ss += __shfl_xor(ss, 1); ss += __shfl_xor(ss, 2); ss += __shfl_xor(ss, 4); ss += __shfl_xor(ss, 8); ss += __shfl_xor(ss, 16);
                    const float rstd = 1.0f / sqrtf(ss * (1.f / 192.f) + EPS);
                    float o[8];
#pragma unroll
                    for (int e = 0; e < 8; ++e) { const float y = v[e] * rstd * (which ? gk[e] : gq[e]); const float p = __shfl_xor(y, 4);
                        float r = y; if (rlo) r = y * cs[e] - p * sn[e]; if (rhi) r = y * cs[e] + p * sn[e]; o[e] = r * osc; }
                    if (act) st16(dst + (size_t)row * 3072 + head * 192 + sub * 8, pack8(o));
                }
            }
        }
        for (int pass = 0; pass < 4; ++pass) {
            __syncthreads();
#pragma unroll
            for (int k = 0; k < 4; ++k) { const int idx = tid + 512 * k, r = idx >> 6, c = idx & 63, hl = c >> 4, cc = c & 15;
                *(LAS u32x4*)(lds + r * TP_PITCH + 16 * c) = ld16(KVRAW + (size_t)(s0 + r) * 4096 + (4 * pass + hl) * 256 + 128 + 8 * cc); }
            __syncthreads();
            tp_store(lds, VAT + (size_t)(512 * pass) * SEQ, s0, tid);
        }
        __syncthreads();
    }
}

namespace att {
__device__ __forceinline__ int swap23(int i) { return (i & ~12) | ((i & 4) << 1) | ((i & 8) >> 1); }
__device__ __forceinline__ void glds16(const void* gsrc, unsigned lds_dst) { unsigned keep;
    asm volatile("s_mov_b32 %0, m0\n\ts_mov_b32 m0, %2\n\ts_nop 0\n\tglobal_load_lds_dwordx4 %1, off\n\ts_mov_b32 m0, %0" : "=&s"(keep) : "v"(gsrc), "s"(lds_dst) : "memory"); }
#define ATT_WAIT_BAR() asm volatile("s_waitcnt vmcnt(0) lgkmcnt(0)\n\ts_barrier" ::: "memory")
__device__ __forceinline__ int crow(int r, int hi) { return (r & 3) + 8 * (r >> 2) + 4 * hi; }

#define ATT_SB() do { asm volatile("" ::: "memory"); __builtin_amdgcn_sched_barrier(0); } while (0)
template <int ND_A, int ND_B>
__device__ __forceinline__ bf16x8 frag_load(const LAS unsigned char* kA, const LAS unsigned char* kB, const LAS unsigned char* vt, int e, int kb, int r32, int xk, int xv) {
    constexpr int ND = ND_A + ND_B;
    if (e < ND_A) return *(const LAS bf16x8*)(kA + (32 * kb + r32) * 256 + (((2 * e) ^ xk) << 4));
    if (e < ND) return *(const LAS bf16x8*)(kB + (32 * kb + r32) * 128 + (((2 * (e - ND_A)) ^ xv) << 4));
    const int db = (e - ND) >> 1, ss = (e - ND) & 1;
    return *(const LAS bf16x8*)(vt + (32 * db + r32) * 128 + (((4 * kb + 2 * ss) ^ xv) << 4));
}
template <int ND_A, int ND_B, int NDB, int PD>
__device__ __forceinline__ void tile_compute(const bf16x8 (&fpre)[PD], const LAS unsigned char* kA, const LAS unsigned char* kB, const LAS unsigned char* vt, const bf16x8* qf, f32x16* o, float& lsum, int r32, int hi) {
    constexpr int ND = ND_A + ND_B, TOT = ND + 2 * NDB;
    bf16x8 f[2][TOT + PD];
#pragma unroll
    for (int i = 0; i < PD; ++i) f[0][i] = fpre[i];
    const int r32in = r32;
#pragma unroll
    for (int kb = 0; kb < 2; ++kb) {
        int r32 = r32in; asm volatile("" : "+v"(r32));
        const int xk = (r32 & 15) ^ hi, xv = ((r32 >> 1) & 7) ^ hi;
        f32x16 s = {0.f, 0.f, 0.f, 0.f, 0.f, 0.f, 0.f, 0.f, 0.f, 0.f, 0.f, 0.f, 0.f, 0.f, 0.f, 0.f};
#pragma unroll
        for (int e = 0; e < ND; ++e) {
            f[kb][e + PD] = frag_load<ND_A, ND_B>(kA, kB, vt, e + PD, kb, r32, xk, xv);
            s = __builtin_amdgcn_mfma_f32_32x32x16_bf16(f[kb][e], qf[e], s, 0, 0, 0);
            ATT_SB();
        }
        float la = 0.f, lb = 0.f; u32x4 w0, w1;
        { const float p0 = __builtin_amdgcn_exp2f(s[0]), p1 = __builtin_amdgcn_exp2f(s[1]), p2 = __builtin_amdgcn_exp2f(s[2]), p3 = __builtin_amdgcn_exp2f(s[3]); la += p0 + p2; lb += p1 + p3; w0.x = pg8::pk_bf16(p0, p1); w0.y = pg8::pk_bf16(p2, p3); }
        { const float p0 = __builtin_amdgcn_exp2f(s[4]), p1 = __builtin_amdgcn_exp2f(s[5]), p2 = __builtin_amdgcn_exp2f(s[6]), p3 = __builtin_amdgcn_exp2f(s[7]); la += p0 + p2; lb += p1 + p3; w0.z = pg8::pk_bf16(p0, p1); w0.w = pg8::pk_bf16(p2, p3); }
        { const float p0 = __builtin_amdgcn_exp2f(s[8]), p1 = __builtin_amdgcn_exp2f(s[9]), p2 = __builtin_amdgcn_exp2f(s[10]), p3 = __builtin_amdgcn_exp2f(s[11]); la += p0 + p2; lb += p1 + p3; w1.x = pg8::pk_bf16(p0, p1); w1.y = pg8::pk_bf16(p2, p3); }
        { const float p0 = __builtin_amdgcn_exp2f(s[12]), p1 = __builtin_amdgcn_exp2f(s[13]), p2 = __builtin_amdgcn_exp2f(s[14]), p3 = __builtin_amdgcn_exp2f(s[15]); la += p0 + p2; lb += p1 + p3; w1.z = pg8::pk_bf16(p0, p1); w1.w = pg8::pk_bf16(p2, p3); }
        lsum += la + lb;
        const bf16x8 pb0 = __builtin_bit_cast(bf16x8, w0), pb1 = __builtin_bit_cast(bf16x8, w1);
        ATT_SB();
#pragma unroll
        for (int e = ND; e < TOT; ++e) {
            if (e + PD < TOT) f[kb][e + PD] = frag_load<ND_A, ND_B>(kA, kB, vt, e + PD, kb, r32, xk, xv);
            else if (kb == 0) f[1][e + PD - TOT] = frag_load<ND_A, ND_B>(kA, kB, vt, e + PD - TOT, 1, r32, xk, xv);
            const int db = (e - ND) >> 1;
            o[db] = __builtin_amdgcn_mfma_f32_32x32x16_bf16(f[kb][e], ((e - ND) & 1) ? pb1 : pb0, o[db], 0, 0, 0);
            ATT_SB();
        }
    }
}

template <int ND_A, int ND_B, int NDB>
__device__ __forceinline__ void tile_compute_simple(const LAS unsigned char* kA, const LAS unsigned char* kB, const LAS unsigned char* vt, const bf16x8* qf, f32x16* o, float& lsum, int r32, int hi) {
    static_assert(ND_B == 0, "simple form: one K region");
    const int xk = (r32 & 15) ^ hi, xv = ((r32 >> 1) & 7) ^ hi;
#pragma unroll
    for (int kb = 0; kb < 2; ++kb) {
        f32x16 s = {0.f, 0.f, 0.f, 0.f, 0.f, 0.f, 0.f, 0.f, 0.f, 0.f, 0.f, 0.f, 0.f, 0.f, 0.f, 0.f};
        const LAS unsigned char* ka = kA + (32 * kb + r32) * 256;
        bf16x8 a = *(const LAS bf16x8*)(ka + ((0 ^ xk) << 4));
#pragma unroll
        for (int d0 = 0; d0 < ND_A; ++d0) { bf16x8 an = a; if (d0 + 1 < ND_A) an = *(const LAS bf16x8*)(ka + (((2 * (d0 + 1)) ^ xk) << 4));
            s = __builtin_amdgcn_mfma_f32_32x32x16_bf16(a, qf[d0], s, 0, 0, 0); a = an; __builtin_amdgcn_sched_barrier(0); }
        const LAS unsigned char* vr = vt + r32 * 128;
        bf16x8 v0 = *(const LAS bf16x8*)(vr + (((4 * kb) ^ xv) << 4)), v1 = *(const LAS bf16x8*)(vr + (((4 * kb + 2) ^ xv) << 4));
        float p[16];
#pragma unroll
        for (int r = 0; r < 16; ++r) { p[r] = __builtin_amdgcn_exp2f(s[r]); lsum += p[r]; }
        u32x4 w0, w1; w0.x = pg8::pk_bf16(p[0], p[1]); w0.y = pg8::pk_bf16(p[2], p[3]); w0.z = pg8::pk_bf16(p[4], p[5]); w0.w = pg8::pk_bf16(p[6], p[7]);
        w1.x = pg8::pk_bf16(p[8], p[9]); w1.y = pg8::pk_bf16(p[10], p[11]); w1.z = pg8::pk_bf16(p[12], p[13]); w1.w = pg8::pk_bf16(p[14], p[15]);
        const bf16x8 pb0 = __builtin_bit_cast(bf16x8, w0), pb1 = __builtin_bit_cast(bf16x8, w1);
        __builtin_amdgcn_sched_barrier(0);
#pragma unroll
        for (int db = 0; db < NDB; ++db) { bf16x8 n0 = v0, n1 = v1;
            if (db + 1 < NDB) { n0 = *(const LAS bf16x8*)(vr + (db + 1) * 4096 + (((4 * kb) ^ xv) << 4)); n1 = *(const LAS bf16x8*)(vr + (db + 1) * 4096 + (((4 * kb + 2) ^ xv) << 4)); }
            o[db] = __builtin_amdgcn_mfma_f32_32x32x16_bf16(v0, pb0, o[db], 0, 0, 0); o[db] = __builtin_amdgcn_mfma_f32_32x32x16_bf16(v1, pb1, o[db], 0, 0, 0); v0 = n0; v1 = n1; __builtin_amdgcn_sched_barrier(0); }
    }
}

constexpr int MLA_STAGE = 40960, DIFF_STAGE = 65536;
#ifndef DIFF_PD
#define DIFF_PD 0
#endif
__device__ __forceinline__ void glds16s(unsigned voff, const void* sbase, unsigned lds_dst) { unsigned keep;
    asm volatile("s_nop 3\n\ts_mov_b32 %0, m0\n\ts_mov_b32 m0, %3\n\ts_nop 0\n\tglobal_load_lds_dwordx4 %1, %2\n\ts_mov_b32 m0, %0" : "=&s"(keep) : "v"(voff), "s"(sbase), "s"(lds_dst) : "memory"); }
__device__ __forceinline__ void mla_stage(const char* Kb, const char* Vb, int t, unsigned dst, int wave, int lane) {
    asm volatile("" : "+v"(lane));
    const unsigned q = lane >> 4, g3 = lane >> 3;
    const unsigned Bn = ((lane & 15) ^ q) * 16, Br = ((lane & 7) ^ q) * 16;
    const int w0 = wave & 1, w1 = (wave >> 1) & 1, w2 = wave >> 2;
    const char* kbase = Kb + (size_t)(64 * t + 32 * w2 + 16 * w1 + 4 * w0) * 6144;
#pragma unroll
    for (int j = 0; j < 2; ++j)
        glds16s(q * 6144 + (Bn ^ (unsigned)(128 * w0 + 64 * j)), kbase + (size_t)(8 * j) * 6144, (unsigned)__builtin_amdgcn_readfirstlane(dst + (2 * wave + j) * 1024));
    glds16s((8 * (lane >> 5) + (g3 & 3)) * 6144 + (Br ^ (unsigned)(64 * w0)), kbase + 256, (unsigned)__builtin_amdgcn_readfirstlane(dst + 16384 + wave * 1024));
    const char* vbase = Vb + (size_t)(2 * wave) * 8 * (SEQ * 2) + t * 128;
#pragma unroll
    for (int j = 0; j < 2; ++j)
        glds16s(g3 * (SEQ * 2) + (Br ^ (unsigned)(64 * j)), vbase + (size_t)j * 8 * (SEQ * 2), (unsigned)__builtin_amdgcn_readfirstlane(dst + 24576 + (2 * wave + j) * 1024));
}
__device__ __forceinline__ void diff_stage(const char* Kb, const char* Vb, int t, unsigned dst, int wave, int lane) {
    asm volatile("" : "+v"(lane));
    const unsigned q = lane >> 4;
    if (wave < 4) {
        const unsigned A = q * 4096, B = ((lane & 15) ^ q) * 16;
        const char* base = Kb + (wave >> 1) * 256 + (size_t)(64 * t + 32 * (wave & 1)) * 4096;
#pragma unroll
        for (int k = 0; k < 8; ++k) { const int Kk = 16 * (k >> 2) + 8 * (k & 1) + 4 * ((k >> 1) & 1);
            glds16s(A + (B ^ (unsigned)(64 * (k & 3))), base + (size_t)Kk * 4096, (unsigned)__builtin_amdgcn_readfirstlane(dst + (wave * 8 + k) * 1024)); }
    } else {
        const unsigned A = (lane >> 3) * (SEQ * 2), B = ((lane & 7) ^ q) * 16;
        const char* base = Vb + (size_t)(wave - 4) * 64 * (SEQ * 2) + t * 128;
#pragma unroll
        for (int k = 0; k < 8; ++k)
            glds16s(A + (B ^ (unsigned)(64 * (k & 1))), base + (size_t)k * 8 * (SEQ * 2), (unsigned)__builtin_amdgcn_readfirstlane(dst + (wave * 8 + k) * 1024));
    }
}

__device__ __forceinline__ void mla_unit(int h, int qb, const bf16* QA, const bf16* KA, const bf16* VAT, bf16* OC, LAS unsigned char* lds, int wave, int lane) {
    const int r32 = lane & 31, hi = lane >> 5; const unsigned lds0 = (unsigned)(uintptr_t)lds;
    const int row = 256 * qb + 32 * wave + r32, cw = 4 * qb + (wave >> 1), NT = 4 * qb + 4;
    const char* Kb = (const char*)(KA + h * 192); const char* Vb = (const char*)(VAT + (size_t)h * 128 * SEQ);
    mla_stage(Kb, Vb, 0, lds0, wave, lane);
    bf16x8 qf[12];
#pragma unroll
    for (int d0 = 0; d0 < 12; ++d0) qf[d0] = *(const bf16x8*)(QA + (size_t)row * 3072 + h * 192 + 16 * d0 + 8 * hi);
#pragma unroll
    for (int d0 = 0; d0 < 12; ++d0) asm volatile("" : "+v"(qf[d0]));
    f32x16 o[4];
#pragma unroll
    for (int db = 0; db < 4; ++db)
#pragma unroll
        for (int r = 0; r < 16; ++r) o[db][r] = 0.f;
    float lsum = 0.f;
    for (int t = 0; t < NT; ++t) {
        ATT_WAIT_BAR();
        const LAS unsigned char* sb = lds + (t & 1) * MLA_STAGE; int r32o = r32; asm volatile("" : "+v"(r32o));
        bf16x8 fp[2];
        if (t <= cw) { fp[0] = frag_load<8, 4>(sb, sb + 16384, sb + 24576, 0, 0, r32o, (r32o & 15) ^ hi, ((r32o >> 1) & 7) ^ hi); fp[1] = frag_load<8, 4>(sb, sb + 16384, sb + 24576, 1, 0, r32o, (r32o & 15) ^ hi, ((r32o >> 1) & 7) ^ hi); }
        if (t + 1 < NT) mla_stage(Kb, Vb, t + 1, lds0 + ((t + 1) & 1) * MLA_STAGE, wave, lane);
        if (t <= cw) tile_compute<8, 4, 4, 2>(fp, sb, sb + 16384, sb + 24576, qf, o, lsum, r32o, hi);
    }
    lsum += __shfl_xor(lsum, 32);
    const float inv = 1.0f / lsum;
    bf16* orow = OC + (size_t)row * 4096 + h * 128;
#pragma unroll
    for (int db = 0; db < 4; ++db)
#pragma unroll
        for (int g4 = 0; g4 < 4; ++g4) { u32x2 w; w.x = pg8::pk_bf16(o[db][4 * g4] * inv, o[db][4 * g4 + 1] * inv); w.y = pg8::pk_bf16(o[db][4 * g4 + 2] * inv, o[db][4 * g4 + 3] * inv);
            *(u32x2*)(orow + 32 * db + 8 * g4 + 4 * hi) = w; }
    ATT_WAIT_BAR();
}

__device__ __forceinline__ void diff_unit(int h, int j, float lam, const bf16* QD, const bf16* KD, const bf16* VDT, const float* gsub, bf16* OC, LAS unsigned char* lds, int wave, int lane) {
    const int r32 = lane & 31, hi = lane >> 5, m = wave >> 2, qs = wave & 3; const unsigned lds0 = (unsigned)(uintptr_t)lds;
    const int row = 128 * j + 32 * qs + r32, cw = 2 * j + (qs >> 1), NT = 2 * j + 2;
    const char* Kb = (const char*)(KD + (h * 2) * 128); const char* Vb = (const char*)(VDT + (size_t)h * 256 * SEQ);
    diff_stage(Kb, Vb, 0, lds0, wave, lane);
    bf16x8 qf[8];
#pragma unroll
    for (int d0 = 0; d0 < 8; ++d0) qf[d0] = *(const bf16x8*)(QD + (size_t)row * 2048 + (h * 2 + m) * 128 + 16 * d0 + 8 * hi);
#pragma unroll
    for (int d0 = 0; d0 < 8; ++d0) asm volatile("" : "+v"(qf[d0]));
    f32x16 o[8];
#pragma unroll
    for (int db = 0; db < 8; ++db)
#pragma unroll
        for (int r = 0; r < 16; ++r) o[db][r] = 0.f;
    float lsum = 0.f;
    for (int t = 0; t < NT; ++t) {
        ATT_WAIT_BAR();
        const LAS unsigned char* sb = lds + (t & 1) * DIFF_STAGE; int r32o = r32; asm volatile("" : "+v"(r32o));
#if DIFF_PD == 0
        if (t + 1 < NT) diff_stage(Kb, Vb, t + 1, lds0 + ((t + 1) & 1) * DIFF_STAGE, wave, lane);
        if (t <= cw) tile_compute_simple<8, 0, 8>(sb + m * 16384, sb, sb + 32768, qf, o, lsum, r32o, hi);
#else
        bf16x8 fp[DIFF_PD];
        if (t <= cw) {
#pragma unroll
            for (int i = 0; i < DIFF_PD; ++i) fp[i] = frag_load<8, 0>(sb + m * 16384, sb, sb + 32768, i, 0, r32o, (r32o & 15) ^ hi, ((r32o >> 1) & 7) ^ hi); }
        if (t + 1 < NT) diff_stage(Kb, Vb, t + 1, lds0 + ((t + 1) & 1) * DIFF_STAGE, wave, lane);
        if (t <= cw) tile_compute<8, 0, 8, DIFF_PD>(fp, sb + m * 16384, sb, sb + 32768, qf, o, lsum, r32o, hi);
#endif
    }
    lsum += __shfl_xor(lsum, 32);
    ATT_WAIT_BAR();
    LAS float* X = (LAS float*)lds;
    if (m == 1) { const float f = lam / lsum;
#pragma unroll
        for (int db = 0; db < 8; ++db)
#pragma unroll
            for (int r = 0; r < 16; ++r) X[(32 * db + crow(r, hi)) * 128 + 32 * qs + r32] = o[db][r] * f; }
    ATT_WAIT_BAR();
    if (m == 0) { const float inv = 1.0f / lsum; float ss = 0.f;
#pragma unroll
        for (int db = 0; db < 8; ++db)
#pragma unroll
            for (int r = 0; r < 16; ++r) { const float v = o[db][r] * inv - X[(32 * db + crow(r, hi)) * 128 + 32 * qs + r32]; o[db][r] = v; ss += v * v; }
        ss += __shfl_xor(ss, 32);
        const float sc = (1.0f - LAMBDA_INIT) / sqrtf(ss * (1.f / 256.f) + EPS);
        bf16* orow = OC + (size_t)row * 4096 + 2048 + h * 256;
#pragma unroll
        for (int db = 0; db < 8; ++db)
#pragma unroll
            for (int g4 = 0; g4 < 4; ++g4) { const int dv0 = 32 * db + 8 * g4 + 4 * hi; const f32x4 g = *(const f32x4*)(gsub + dv0);
                u32x2 w; w.x = pg8::pk_bf16(o[db][4 * g4] * sc * g.x, o[db][4 * g4 + 1] * sc * g.y); w.y = pg8::pk_bf16(o[db][4 * g4 + 2] * sc * g.z, o[db][4 * g4 + 3] * sc * g.w);
                *(u32x2*)(orow + dv0) = w; } }
    ATT_WAIT_BAR();
}
}

__device__ __forceinline__ int fresh_lane() { int l = (int)__builtin_amdgcn_mbcnt_hi(~0u, __builtin_amdgcn_mbcnt_lo(~0u, 0u)); asm volatile("" : "+v"(l)); return l; }
constexpr int I_IN = (DM / 64) * (DIN / 32), I_UQ = (768 / 64) * (3072 / 32), I_UKV = (512 / 64) * (4096 / 32), I_O = (DM / 64) * (DM / 32), I_G = (DM / 64) * (DFF / 32), I_D = (DFF / 64) * (DM / 32);
constexpr int NG1 = 13000, ND8 = 19000, NU3 = 8000, SPARE1 = 16, SPARE8 = 5;
static_assert(NG1 <= I_G && ND8 <= I_D, "deferred item counts");
__global__ void __launch_bounds__(NWAVES * 64) fwd_kernel(Args A) {
    extern __shared__ __attribute__((aligned(16))) unsigned char lds_raw[];
    LAS unsigned char* lds = (LAS unsigned char*)lds_raw;
    cg::grid_group grid = cg::this_grid();
    const int wave = __builtin_amdgcn_readfirstlane((int)threadIdx.x >> 6);
    const int lane = (int)__builtin_amdgcn_mbcnt_hi(~0u, __builtin_amdgcn_mbcnt_lo(~0u, 0u)), tid = wave * 64 + lane;
    const int G = gridDim.x, bx = blockIdx.x; const int vcu = (G % 8 == 0) ? (bx % 8) * (G / 8) + bx / 8 : bx;
    unsigned char* ws = A.ws;
    const int lo = A.ph_lo, hi = A.ph_hi;
#define IN(k) (lo <= (k) && (k) < hi)
#ifndef PROBE_MASK
#define PROBE_MASK 0
#endif
#define REPS(k) for (int rep_ = 0; rep_ < (((PROBE_MASK >> (k)) & 1) ? 2 : 1); ++rep_)
    volatile LAS unsigned* bst = (volatile LAS unsigned*)(lds + LDS_BYTES - 64);
    if (tid < 2) bst[tid] = 0u;
    __syncthreads();
    XcdBarrier bar; bar.bar = (unsigned*)(ws + WS_BAR); bar.x = 0; bar.st = bst;
    const bool t0 = (tid == 0);
    if (hi - lo > 1) bar = xcd_barrier_post((unsigned*)(ws + WS_BAR), bst, t0);
#define SEAM(k) do { if (IN(k) && IN((k) + 1)) { if ((k) == 0) grid.sync(); else xcd_barrier(bar, t0); } } while (0)
    bf16* XN = (bf16*)(ws + WS_XN);

    if (IN(0)) REPS(0) {
        LAS float* scr = (LAS float*)(lds + wave * 16384);
        const int gw = vcu * NWAVES + wave, NGW = G * NWAVES;
        const int ng1 = (G >= 64) ? NG1 : 0, nd8 = (G >= 64) ? ND8 : 0, nu3 = (G >= 64) ? NU3 : 0, wo0 = (G >= 64) ? 0 : I_O;
        {
            int base = 0;
#define P0_STREAM(W_, K_, N_, WT_, MODE_, FIRST_, CNT_) do { const int b_ = ((gw - base) % NGW + NGW) % NGW; \
                conv_stream(W_, K_, N_, WT_, MODE_, scr, (FIRST_) + b_, (FIRST_) + (CNT_), NGW, lane, ((MODE_) != 0) ? A.in[17] : nullptr); base += (CNT_); } while (0)
            P0_STREAM(A.in[2], DM, DIN, (bf16*)(ws + WS_WIN), 0, 0, I_IN);
            P0_STREAM(A.in[5], 768, 3072, (bf16*)(ws + WS_WUQ), 0, 0, I_UQ);
            P0_STREAM(A.in[6], 512, 4096, (bf16*)(ws + WS_WUKV), 0, 0, I_UKV);
            P0_STREAM(A.in[16], DM, DM, (bf16*)(ws + WS_WO), 0, 0, wo0);
            P0_STREAM(A.in[18], DM, DFF, (bf16*)(ws + WS_WGU), 1, ng1, I_G - ng1);
            P0_STREAM(A.in[19], DM, DFF, (bf16*)(ws + WS_WGU), 2, nu3, I_G - nu3);
            P0_STREAM(A.in[20], DFF, DM, (bf16*)(ws + WS_WDN), 0, nd8, I_D - nd8);
#undef P0_STREAM
        }
        { u32x4* pz = (u32x4*)(ws + WS_WIN + (size_t)DIN * DM * 2); const int n16 = (ZLD - DIN) * DM * 2 / 16; const u32x4 z4 = {0u, 0u, 0u, 0u};
            for (int i = vcu * 512 + tid; i < n16; i += G * 512) pz[i] = z4; }
        for (int mrow = gw; mrow < SEQ; mrow += NGW) rms_row_4096(A.in[0] + (size_t)mrow * DM, A.in[1], XN + (size_t)mrow * DM, lane);
        { float* rowss = (float*)(ws + WS_ROWSS); for (int i = vcu * 512 + tid; i < SEQ; i += G * 512) rowss[i] = 0.f; }
    }
    SEAM(0);
    if (IN(1)) REPS(1) {
        const int spare = (G >= 64) ? SPARE1 : 0, Gg = G - spare;
        if (bx < Gg) {
            pg8::Gemm g{XN, (const bf16*)(ws + WS_WIN), SEQ, ZLD, DM}; pg8::StaticOrder S; S.init(SEQ, ZLD, Gg, bx);
            pg8::EpiBf16S E{(bf16*)(ws + WS_Z), ZLD};
            pg8::gemm_phase<pg8::EpiBf16S, pg8::StaticOrder, true, true>(lds, g, S, E, tid);
        } else {
            LAS float* scr = (LAS float*)(lds + wave * 16384);
            const int sw = (bx - Gg) * NWAVES + wave, ns = spare * NWAVES;
            conv_stream(A.in[16], DM, DM, (bf16*)(ws + WS_WO), 0, scr, sw, I_O, ns, lane);
            conv_stream(A.in[18], DM, DFF, (bf16*)(ws + WS_WGU), 1, scr, sw, NG1, ns, lane, A.in[17]);
        }
    }
    SEAM(1);
    if (IN(2)) REPS(2) p2_phase(A, lds, vcu, G, tid, wave, lane);
    SEAM(2);
    if (IN(3)) REPS(3) {
        { pg8::Gemm g{(const bf16*)(ws + WS_CQN), (const bf16*)(ws + WS_WUQ), SEQ, 3072, 768}; pg8::StaticOrder S; S.init(SEQ, 3072, G, G - 1 - bx);
          pg8::EpiBf16S E{(bf16*)(ws + WS_QRAW), 3072};
          pg8::gemm_phase<pg8::EpiBf16S, pg8::StaticOrder, true, true>(lds, g, S, E, tid); }
        { pg8::Gemm g{(const bf16*)(ws + WS_CKVN), (const bf16*)(ws + WS_WUKV), SEQ, 4096, 512}; pg8::StaticOrder S; S.init(SEQ, 4096, G, bx);
          pg8::EpiBf16S E{(bf16*)(ws + WS_KVRAW), 4096};
          pg8::gemm_phase<pg8::EpiBf16S, pg8::StaticOrder, true, true>(lds, g, S, E, tid); }
        if (G >= 64 && bx < G / 2)
            conv_stream(A.in[19], DM, DFF, (bf16*)(ws + WS_WGU), 2, (LAS float*)(lds + wave * 16384), bx * NWAVES + wave, NU3, (G / 2) * NWAVES, lane, A.in[17]);
    }
    SEAM(3);
    if (IN(4)) REPS(4) p4_phase(A, lds, vcu, G, tid, wave, lane);
    SEAM(4);
    if (IN(5)) {
        float lam;
        { const float* q1 = A.in[11]; const float* k1 = A.in[12]; const float* q2 = A.in[13]; const float* k2 = A.in[14];
          const float s1 = wave_sum(q1[lane] * k1[lane] + q1[lane + 64] * k1[lane + 64]), s2 = wave_sum(q2[lane] * k2[lane] + q2[lane + 64] * k2[lane + 64]);
          lam = __uint_as_float(__builtin_amdgcn_readfirstlane(__float_as_uint(expf(s1) - expf(s2) + LAMBDA_INIT))); }
        const bf16* QA = (const bf16*)(ws + WS_QA); const bf16* KA = (const bf16*)(ws + WS_KA); const bf16* VAT = (const bf16*)(ws + WS_VAT);
        const bf16* QD = (const bf16*)(ws + WS_QD); const bf16* KD = (const bf16*)(ws + WS_KD); const bf16* VDT = (const bf16*)(ws + WS_VDT);
        bf16* OC = (bf16*)(ws + WS_OC);
        REPS(5) for (int p = vcu; p < 256; p += G) {
            { const int h = p >> 5, s = p & 31; att::diff_unit(h, 63 - s, lam, QD, KD, VDT, A.in[15], OC, lds, wave, lane); att::diff_unit(h, s, lam, QD, KD, VDT, A.in[15], OC, lds, wave, lane); }
            { const int h = p >> 4, s = p & 15; att::mla_unit(h, 31 - s, QA, KA, VAT, OC, lds, wave, lane); att::mla_unit(h, s, QA, KA, VAT, OC, lds, wave, lane); }
        }
    }
    SEAM(5);
    if (IN(6)) REPS(6) {
        pg8::Gemm g{(const bf16*)(ws + WS_OC), (const bf16*)(ws + WS_WO), SEQ, DM, DM}; pg8::StaticOrder S; S.init(SEQ, DM, G, bx);
        pg8::EpiHb E{A.in[0], XN, (float*)(ws + WS_ROWSS), DM};
        pg8::gemm_phase<pg8::EpiHb, pg8::StaticOrder, true, true>(lds, g, S, E, wave * 64 + fresh_lane());
    }
    SEAM(6);
    if (IN(8)) REPS(8) {
        const int spare = (G >= 64) ? SPARE8 : 0, Gg = G - spare;
        if (bx < Gg) {
            pg8::Gemm g{XN, (const bf16*)(ws + WS_WGU), SEQ, 2 * DFF, DM}; pg8::StaticOrder S; S.init(SEQ, 2 * DFF, Gg, bx);
            pg8::EpiSwiGLU E{(bf16*)(ws + WS_ACT), DFF, (const float*)(ws + WS_ROWSS), 1.0f / DM, EPS};
            pg8::gemm_phase<pg8::EpiSwiGLU, pg8::StaticOrder, true, true>(lds, g, S, E, wave * 64 + fresh_lane());
        } else {
            LAS float* scr = (LAS float*)(lds + wave * 16384);
            conv_stream(A.in[20], DFF, DM, (bf16*)(ws + WS_WDN), 0, scr, (bx - Gg) * NWAVES + wave, ND8, spare * NWAVES, fresh_lane());
        }
    }
    SEAM(8);
    if (IN(9)) REPS(9) {
        pg8::Gemm g{(const bf16*)(ws + WS_ACT), (const bf16*)(ws + WS_WDN), SEQ, DM, DFF}; pg8::StaticOrder S; S.init(SEQ, DM, G, bx);
        pg8::EpiOutHb E{XN, A.out, DM};
        pg8::gemm_phase<pg8::EpiOutHb, pg8::StaticOrder, true, true>(lds, g, S, E, wave * 64 + fresh_lane());
    }
#undef IN
#undef SEAM
}

#ifndef MK_PER_PHASE
#define MK_PER_PHASE 0
#endif
constexpr int N_PHASES = 10;
extern "C" void kernel_launch(void* const* d_in, const int* in_sizes, int n_in, void* d_out, int out_size, void* d_ws, size_t ws_size, hipStream_t stream) {
    static int grid = 0;
    if (grid == 0) {
        if (n_in != 21 || in_sizes[0] != SEQ * DM || out_size != SEQ * DM || ws_size < WS_END) { fprintf(stderr, "kernel_launch: unexpected shapes / workspace (n_in %d, ws %zu, need %zu)\n", n_in, ws_size, (size_t)WS_END); grid = -1; return; }
        int dev = 0, cus = 0, per_cu = 0;
        if (hipGetDevice(&dev) != hipSuccess || hipDeviceGetAttribute(&cus, hipDeviceAttributeMultiprocessorCount, dev) != hipSuccess) { grid = -1; return; }
        if (hipFuncSetAttribute((const void*)fwd_kernel, hipFuncAttributeMaxDynamicSharedMemorySize, LDS_BYTES) != hipSuccess) { fprintf(stderr, "kernel_launch: hipFuncSetAttribute failed\n"); grid = -1; return; }
        if (hipOccupancyMaxActiveBlocksPerMultiprocessor(&per_cu, (const void*)fwd_kernel, NWAVES * 64, LDS_BYTES) != hipSuccess || per_cu < 1) { fprintf(stderr, "kernel_launch: occupancy query gave %d\n", per_cu); per_cu = 1; }
        (void)hipGetLastError();
        grid = cus * per_cu;
    }
    if (grid < 0) return;
    if (hipMemsetAsync((char*)d_ws + WS_BAR, 0, XCD_BAR_WORDS * 4, stream) != hipSuccess) { fprintf(stderr, "kernel_launch: hipMemsetAsync failed\n"); return; }
    Args a{};
    for (int i = 0; i < 21; ++i) a.in[i] = (const float*)d_in[i];
    a.out = (float*)d_out; a.ws = (unsigned char*)d_ws;
    for (int j = 0; j < 64; ++j) a.invf[j] = (float)std::pow(10000.0, -(double)j / 64.0);
#if MK_PER_PHASE
#ifndef HOST_REP_MASK
#define HOST_REP_MASK 0
#endif
    for (int ph = 0; ph < N_PHASES; ++ph) for (int rep = 0; rep < (((HOST_REP_MASK >> ph) & 1) ? 2 : 1); ++rep) { a.ph_lo = ph; a.ph_hi = ph + 1; hipLaunchKernelGGL(fwd_kernel, dim3(grid), dim3(NWAVES * 64), LDS_BYTES, stream, a); }
#else
    a.ph_lo = 0; a.ph_hi = N_PHASES;
    void* args[] = {&a};
    hipError_t e = hipLaunchCooperativeKernel((const void*)fwd_kernel, dim3(grid), dim3(NWAVES * 64), args, LDS_BYTES, stream);
    if (e != hipSuccess) fprintf(stderr, "kernel_launch: cooperative launch failed: %s (grid %d)\n", hipGetErrorString(e), grid);
#endif
}
```

```cpp
#include <hip/hip_runtime.h>
#include <hip/hip_cooperative_groups.h>
#include <cstdio>
#include <cstdint>
#include <cmath>
namespace cg = cooperative_groups;
namespace pg8 {
#define PG8_LAS __attribute__((address_space(3)))
typedef unsigned short bf16_t;
typedef short bf16x8 __attribute__((ext_vector_type(8)));
typedef float f32x4 __attribute__((ext_vector_type(4)));
typedef unsigned u32x4 __attribute__((ext_vector_type(4)));
constexpr int BM = 256, BK = 64, HALF = 128, HTB = HALF * BK * 2  , STAGE_BYTES = 8 * HTB, NXCD = 8, WGM = 8;

__host__ __device__ __forceinline__ int lds_byte(int r, int c) { const int st = (r >> 4) * 2 + (c >> 5), rr = r & 15, cc = c & 31, ob = rr * 64 + cc * 2; return st * 1024 + (ob ^ (((ob >> 9) & 1) << 5)); }
__host__ __device__ __forceinline__ void stage_rc(int b, int& R, int& C) { const int st = b / 1024, sb = b % 1024, swz = sb ^ (((sb >> 9) & 1) << 5); R = (st >> 1) * 16 + swz / 64; C = (st & 1) * 32 + (swz % 64) / 2; }
__host__ __device__ __forceinline__ int perm32(int rho) { const int n = rho >> 4, i = rho & 15; return 8 * (i >> 2) + 4 * n + (i & 3); }

struct Unit { int pm, pn; };
struct Gemm { const bf16_t* A; const bf16_t* Bt; int M, N, K; };

struct StaticOrder {
    int nM, nN, nwg, G, c;
    __host__ __device__ void init(int M, int N, int G_, int c_) { nM = M / BM; nN = N / BM; nwg = nM * nN; G = G_; c = c_; }
    __host__ __device__ bool next(int i, Unit& u) const {
        const long L = (long)i * G + c; if (L >= nwg) return false;
        int wgid = (int)L; { const int q = nwg / NXCD, r = nwg % NXCD, xcd = wgid % NXCD, off = wgid / NXCD; wgid = (xcd < r ? xcd * (q + 1) : r * (q + 1) + (xcd - r) * q) + off; }
        const int nig = WGM * nN, gid = wgid / nig, fm = gid * WGM, gsz = (nM - fm) < WGM ? (nM - fm) : WGM;
        u.pm = fm + ((wgid % nig) % gsz); u.pn = (wgid % nig) / gsz; return true;
    }
    __device__ __forceinline__ void a_ready(const Unit&) const {}
    __device__ __forceinline__ void done(const Unit&) const {}
};

__device__ __forceinline__ unsigned cvt_pk_bf16(float lo, float hi) { unsigned r; asm volatile("v_cvt_pk_bf16_f32 %0, %1, %2" : "=v"(r) : "v"(lo), "v"(hi)); return r; }
typedef float f32x2 __attribute__((ext_vector_type(2)));
template <class Epi, class Sched, bool ALIGN_EPI = false, bool SP2 = false>
__device__ __forceinline__ void gemm_phase(PG8_LAS unsigned char* lds, const Gemm g, const Sched& S, const Epi& E, const int tid_in) {
    const int tid = tid_in, wid = __builtin_amdgcn_readfirstlane(tid >> 6), lane = tid & 63, wr = wid >> 2, wc = wid & 3, fr = lane & 15, fq = lane >> 4;
    const int K = g.K, nt = K / BK;
    unsigned voffA[2], voffB[2];
#pragma unroll
    for (int i = 0; i < 2; ++i) { int R, C; stage_rc(tid * 16 + i * 8192, R, C); const int Rb = Epi::PERM ? ((R & ~31) + perm32(R & 31)) : R;
        voffA[i] = (unsigned)(R * K + C) * 2u; voffB[i] = (unsigned)(Rb * K + C) * 2u; }
    const size_t kstep = (size_t)(BK * 2);
    const size_t hstep = (size_t)HALF * K * 2;
    const size_t tstep = 2 * hstep;
    const unsigned ldsw = (unsigned)wid * 1024u;
    const int aoff = lds_byte(wr * 64 + fr, fq * 8), boff = lds_byte(wc * 32 + fr, fq * 8);
#define PG8_SA(b, h) (((b) * 2 + (h)) * HTB)
#define PG8_SB(b, h) ((4 + (b) * 2 + (h)) * HTB)
#define PG8_STAGE(bufoff, gbase, voff) do { _Pragma("unroll") for (int _i = 0; _i < 2; ++_i) \
        __builtin_amdgcn_global_load_lds((const unsigned*)((const char*)(gbase) + (voff)[_i]), (PG8_LAS unsigned*)(lds + (bufoff) + ldsw + _i * 8192), 16, 0, 0); } while (0)
#define PG8_LDA(dst, b, h) do { _Pragma("unroll") for (int m = 0; m < 4; ++m) _Pragma("unroll") for (int k = 0; k < 2; ++k) dst[m][k] = *(const PG8_LAS bf16x8*)(lds + PG8_SA(b, h) + aoff + m * 2048 + k * 1024); } while (0)
#define PG8_LDB(dst, b, h) do { _Pragma("unroll") for (int n = 0; n < 2; ++n) _Pragma("unroll") for (int k = 0; k < 2; ++k) dst[n][k] = *(const PG8_LAS bf16x8*)(lds + PG8_SB(b, h) + boff + n * 2048 + k * 1024); } while (0)
#define PG8_MMA(ai, bj, At, Bt) do { __builtin_amdgcn_s_setprio(1); _Pragma("unroll") for (int m = 0; m < 4; ++m) _Pragma("unroll") for (int n = 0; n < 2; ++n) _Pragma("unroll") for (int k = 0; k < 2; ++k) \
        acc[ai][bj][m][n] = __builtin_amdgcn_mfma_f32_16x16x32_bf16(Bt[n][k], At[m][k], acc[ai][bj][m][n], 0, 0, 0); __builtin_amdgcn_s_setprio(0); } while (0)
#define PG8_WAIT_V(n) asm volatile("s_waitcnt vmcnt(" #n ")" ::: "memory")
#define PG8_WAIT_L(n) asm volatile("s_waitcnt lgkmcnt(" #n ")" ::: "memory")
#define PG8_BAR __builtin_amdgcn_s_barrier()
#define PG8_SCHED __builtin_amdgcn_sched_barrier(0)
    Unit cur, nxt; int ui = 0;
    if (!S.next(0, cur)) return;
    f32x4 acc[2][2][4][2];
#pragma unroll
    for (int a = 0; a < 2; ++a)
#pragma unroll
        for (int b = 0; b < 2; ++b)
#pragma unroll
            for (int m = 0; m < 4; ++m)
#pragma unroll
                for (int n = 0; n < 2; ++n) acc[a][b][m][n] = (f32x4){0.f, 0.f, 0.f, 0.f};
    bf16x8 At[4][2], B0[2][2], B1[2][2];
    const char* cA = (const char*)g.A + (size_t)cur.pm * tstep; const char* cB = (const char*)g.Bt + (size_t)cur.pn * tstep;
    S.a_ready(cur);
    if constexpr (SP2) {
        PG8_STAGE(PG8_SB(0, 0), cB, voffB); PG8_STAGE(PG8_SB(0, 1), cB + hstep, voffB); PG8_STAGE(PG8_SA(0, 0), cA, voffA); PG8_STAGE(PG8_SA(0, 1), cA + hstep, voffA);
        if (wr == 1) PG8_BAR;
        PG8_WAIT_V(2); PG8_BAR;
        PG8_STAGE(PG8_SB(1, 0), cB + kstep, voffB); PG8_STAGE(PG8_SA(1, 0), cA + kstep, voffA); PG8_STAGE(PG8_SB(1, 1), cB + hstep + kstep, voffB);
        PG8_WAIT_V(6); PG8_BAR;
    } else {
        PG8_STAGE(PG8_SB(0, 0), cB, voffB); PG8_STAGE(PG8_SA(0, 0), cA, voffA); PG8_STAGE(PG8_SB(0, 1), cB + hstep, voffB); PG8_STAGE(PG8_SA(0, 1), cA + hstep, voffA);
        if (wr == 1) PG8_BAR;
        PG8_WAIT_V(4); PG8_BAR;
        PG8_STAGE(PG8_SB(1, 0), cB + kstep, voffB); PG8_STAGE(PG8_SA(1, 0), cA + kstep, voffA); PG8_STAGE(PG8_SB(1, 1), cB + hstep + kstep, voffB);
        PG8_WAIT_V(6); PG8_BAR;
    }
    for (;;) {
        const bool has_next = S.next(ui + 1, nxt);
        const char* nA = has_next ? (const char*)g.A + (size_t)nxt.pm * tstep : cA; const char* nB = has_next ? (const char*)g.Bt + (size_t)nxt.pn * tstep : cB;
        for (int t = 0; t < nt; t += 2) {
            const bool last = (t == nt - 2);
            const char* a1 = cA + (size_t)(t + 1) * kstep;
            const char* a2 = last ? nA : cA + (size_t)(t + 2) * kstep; const char* b2 = last ? nB : cB + (size_t)(t + 2) * kstep;
            const char* a3 = a2 + kstep; const char* b3 = b2 + kstep;
            if (last && has_next) S.a_ready(nxt);
            if constexpr (SP2) {
            PG8_LDB(B0, 0, 0); PG8_LDB(B1, 0, 1); PG8_SCHED; PG8_LDA(At, 0, 0); PG8_STAGE(PG8_SA(1, 1), a1 + hstep, voffA);
            PG8_WAIT_V(8); PG8_WAIT_L(0); PG8_BAR; PG8_MMA(0, 0, At, B0); PG8_MMA(0, 1, At, B1); PG8_BAR; PG8_SCHED;
            PG8_LDA(At, 0, 1); PG8_STAGE(PG8_SB(0, 0), b2, voffB); PG8_STAGE(PG8_SB(0, 1), b2 + hstep, voffB); PG8_STAGE(PG8_SA(0, 0), a2, voffA);
            PG8_WAIT_V(8); PG8_WAIT_L(0); PG8_BAR; PG8_MMA(1, 0, At, B0); PG8_MMA(1, 1, At, B1); PG8_BAR; PG8_SCHED;
            PG8_LDB(B0, 1, 0); PG8_LDB(B1, 1, 1); PG8_SCHED; PG8_LDA(At, 1, 0); PG8_STAGE(PG8_SA(0, 1), a2 + hstep, voffA);
            PG8_WAIT_V(8); PG8_WAIT_L(0); PG8_BAR; PG8_MMA(0, 0, At, B0); PG8_MMA(0, 1, At, B1); PG8_BAR; PG8_SCHED;
            PG8_LDA(At, 1, 1); PG8_STAGE(PG8_SB(1, 0), b3, voffB); PG8_STAGE(PG8_SB(1, 1), b3 + hstep, voffB); PG8_STAGE(PG8_SA(1, 0), a3, voffA);
            PG8_WAIT_V(8); PG8_WAIT_L(0); PG8_BAR; PG8_MMA(1, 0, At, B0); PG8_MMA(1, 1, At, B1); PG8_BAR; PG8_SCHED;
            } else {
            PG8_LDB(B0, 0, 0); PG8_SCHED; PG8_LDA(At, 0, 0); PG8_STAGE(PG8_SA(1, 1), a1 + hstep, voffA);
            PG8_WAIT_L(8); PG8_BAR; PG8_WAIT_L(0); PG8_MMA(0, 0, At, B0); PG8_BAR; PG8_SCHED;
            PG8_LDB(B1, 0, 1); PG8_STAGE(PG8_SB(0, 0), b2, voffB);
            PG8_BAR; PG8_WAIT_L(0); PG8_MMA(0, 1, At, B1); PG8_BAR;
            PG8_LDA(At, 0, 1); PG8_STAGE(PG8_SA(0, 0), a2, voffA);
            PG8_BAR; PG8_WAIT_L(0); PG8_MMA(1, 0, At, B0); PG8_BAR; PG8_SCHED;
            PG8_STAGE(PG8_SB(0, 1), b2 + hstep, voffB);
            PG8_WAIT_V(6); PG8_BAR; PG8_MMA(1, 1, At, B1); PG8_BAR;
            PG8_LDB(B0, 1, 0); PG8_SCHED; PG8_LDA(At, 1, 0); PG8_STAGE(PG8_SA(0, 1), a2 + hstep, voffA);
            PG8_WAIT_L(8); PG8_BAR; PG8_WAIT_L(0); PG8_MMA(0, 0, At, B0); PG8_BAR; PG8_SCHED;
            PG8_LDB(B1, 1, 1); PG8_STAGE(PG8_SB(1, 0), b3, voffB);
            PG8_BAR; PG8_WAIT_L(0); PG8_MMA(0, 1, At, B1); PG8_BAR;
            PG8_LDA(At, 1, 1); PG8_STAGE(PG8_SA(1, 0), a3, voffA);
            PG8_BAR; PG8_WAIT_L(0); PG8_MMA(1, 0, At, B0); PG8_BAR; PG8_SCHED;
            PG8_STAGE(PG8_SB(1, 1), b3 + hstep, voffB);
            PG8_WAIT_V(6); PG8_BAR; PG8_MMA(1, 1, At, B1); PG8_BAR;
            }
        }
        if constexpr (ALIGN_EPI) { if (wr == 0) PG8_BAR; }
        if constexpr (!Epi::AFTER_DRAIN) { E(acc, cur, wr, wc, fr, fq); S.done(cur); }
        if (!has_next) break;
#pragma unroll
        for (int a = 0; a < 2; ++a)
#pragma unroll
            for (int b = 0; b < 2; ++b)
#pragma unroll
                for (int m = 0; m < 4; ++m)
#pragma unroll
                    for (int n = 0; n < 2; ++n) acc[a][b][m][n] = (f32x4){0.f, 0.f, 0.f, 0.f};
        cur = nxt; cA = nA; cB = nB; ++ui;
        if constexpr (ALIGN_EPI) { if (wr == 1) PG8_BAR; }
    }
    PG8_WAIT_V(0);
    if constexpr (!ALIGN_EPI) { if (wr == 0) PG8_BAR; }
    PG8_BAR;
    if constexpr (Epi::AFTER_DRAIN) { E.fused(acc, cur, wr, wc, fr, fq, lds, wid, lane); S.done(cur); }
#undef PG8_SA
#undef PG8_SB
#undef PG8_STAGE
#undef PG8_LDA
#undef PG8_LDB
#undef PG8_MMA
#undef PG8_WAIT_V
#undef PG8_WAIT_L
#undef PG8_BAR
#undef PG8_SCHED
}
}

namespace pg8 {
typedef float f32x2e __attribute__((ext_vector_type(2))); typedef __bf16 bf16x2e __attribute__((ext_vector_type(2)));
__device__ __forceinline__ unsigned pk_bf16(float lo, float hi) { f32x2e v = {lo, hi}; bf16x2e b = __builtin_convertvector(v, bf16x2e); return __builtin_bit_cast(unsigned, b); }
struct EpiBf16S {
    static constexpr bool PERM = true, AFTER_DRAIN = false;
    bf16_t* O; int ldc;
    __device__ __forceinline__ void operator()(const f32x4 (&acc)[2][2][4][2], const Unit& u, int wr, int wc, int fr, int fq) const {
        const int row0 = u.pm * BM + wr * 64 + fr, col0 = u.pn * BM + wc * 32 + 8 * fq;
#pragma unroll
        for (int ai = 0; ai < 2; ++ai)
#pragma unroll
            for (int m = 0; m < 4; ++m) { bf16_t* rowp = O + (size_t)(row0 + ai * HALF + m * 16) * ldc + col0;
#pragma unroll
                for (int bj = 0; bj < 2; ++bj) { const f32x4 v0 = acc[ai][bj][m][0], v1 = acc[ai][bj][m][1];
                    u32x4 w; w.x = pk_bf16(v0[0], v0[1]); w.y = pk_bf16(v0[2], v0[3]); w.z = pk_bf16(v1[0], v1[1]); w.w = pk_bf16(v1[2], v1[3]);
                    *(u32x4*)(rowp + bj * HALF) = w; } }
    }
};
struct EpiResF32 {
    static constexpr bool PERM = false, AFTER_DRAIN = false;
    const float* base; float* out; int ldc;
    __device__ __forceinline__ void operator()(const f32x4 (&acc)[2][2][4][2], const Unit& u, int wr, int wc, int fr, int fq) const {
        const int col0 = u.pn * BM + wc * 32 + 4 * fq;
#pragma unroll
        for (int ai = 0; ai < 2; ++ai)
#pragma unroll
            for (int m = 0; m < 4; ++m) { const int r = u.pm * BM + ai * HALF + wr * 64 + m * 16 + fr; const size_t off = (size_t)r * ldc + col0;
#pragma unroll
                for (int bj = 0; bj < 2; ++bj)
#pragma unroll
                    for (int n = 0; n < 2; ++n) { const f32x4 b = *(const f32x4*)(base + off + bj * HALF + n * 16); *(f32x4*)(out + off + bj * HALF + n * 16) = b + acc[ai][bj][m][n]; } }
    }
};
struct EpiHb {
    static constexpr bool PERM = true, AFTER_DRAIN = false;
    const float* base; bf16_t* hb; int ldc;
    __device__ __forceinline__ void operator()(const f32x4 (&acc)[2][2][4][2], const Unit& u, int wr, int wc, int fr, int fq) const {
        const int row0 = u.pm * BM + wr * 64 + fr, col0 = u.pn * BM + wc * 32 + 8 * fq;
#pragma unroll
        for (int ai = 0; ai < 2; ++ai)
#pragma unroll
            for (int m = 0; m < 4; ++m) { const size_t off = (size_t)(row0 + ai * HALF + m * 16) * ldc + col0;
#pragma unroll
                for (int bj = 0; bj < 2; ++bj) { const f32x4 h0 = *(const f32x4*)(base + off + bj * HALF) + acc[ai][bj][m][0], h1 = *(const f32x4*)(base + off + bj * HALF + 4) + acc[ai][bj][m][1];
                    u32x4 w; w.x = pk_bf16(h0[0], h0[1]); w.y = pk_bf16(h0[2], h0[3]); w.z = pk_bf16(h1[0], h1[1]); w.w = pk_bf16(h1[2], h1[3]);
                    *(u32x4*)(hb + off + bj * HALF) = w; } }
    }
};
struct EpiOutHb {
    static constexpr bool PERM = false, AFTER_DRAIN = false;
    const bf16_t* hb; float* out; int ldc;
    __device__ __forceinline__ void operator()(const f32x4 (&acc)[2][2][4][2], const Unit& u, int wr, int wc, int fr, int fq) const {
        typedef unsigned u32x2e __attribute__((ext_vector_type(2)));
        const int col0 = u.pn * BM + wc * 32 + 4 * fq;
#pragma unroll
        for (int ai = 0; ai < 2; ++ai)
#pragma unroll
            for (int m = 0; m < 4; ++m) { const int r = u.pm * BM + ai * HALF + wr * 64 + m * 16 + fr; const size_t off = (size_t)r * ldc + col0;
#pragma unroll
                for (int bj = 0; bj < 2; ++bj)
#pragma unroll
                    for (int n = 0; n < 2; ++n) { const u32x2e w = *(const u32x2e*)(hb + off + bj * HALF + n * 16);
                        const f32x4 b = {__uint_as_float(w.x << 16), __uint_as_float(w.x & 0xffff0000u), __uint_as_float(w.y << 16), __uint_as_float(w.y & 0xffff0000u)};
                        *(f32x4*)(out + off + bj * HALF + n * 16) = b + acc[ai][bj][m][n]; } }
    }
};
struct EpiSwiGLU {
    static constexpr bool PERM = true, AFTER_DRAIN = false;
    bf16_t* O; int ldc; const float* rowss; float invk, eps;
    __device__ __forceinline__ static float act(float g, float u) { return g * u * __builtin_amdgcn_rcpf(1.0f + __builtin_amdgcn_exp2f(-1.4426950408889634f * g)); }
    __device__ __forceinline__ void operator()(const f32x4 (&acc)[2][2][4][2], const Unit& u, int wr, int wc, int fr, int fq) const {
        const int row0 = u.pm * BM + wr * 64 + fr, col0 = u.pn * HALF + wc * 32 + 8 * fq;
        float rs[2][4];
#pragma unroll
        for (int ai = 0; ai < 2; ++ai)
#pragma unroll
            for (int m = 0; m < 4; ++m) rs[ai][m] = rowss[row0 + ai * HALF + m * 16];
#pragma unroll
        for (int ai = 0; ai < 2; ++ai)
#pragma unroll
            for (int m = 0; m < 4; ++m) { bf16_t* rowp = O + (size_t)(row0 + ai * HALF + m * 16) * ldc + col0;
                const float r1 = 1.0f / sqrtf(rs[ai][m] * invk + eps);
                const f32x4 g0 = acc[ai][0][m][0] * r1, g1 = acc[ai][0][m][1] * r1, u0 = acc[ai][1][m][0] * r1, u1 = acc[ai][1][m][1] * r1;
                u32x4 w; w.x = pk_bf16(act(g0[0], u0[0]), act(g0[1], u0[1])); w.y = pk_bf16(act(g0[2], u0[2]), act(g0[3], u0[3]));
                w.z = pk_bf16(act(g1[0], u1[0]), act(g1[1], u1[1])); w.w = pk_bf16(act(g1[2], u1[2]), act(g1[3], u1[3]));
                *(u32x4*)(rowp) = w; }
    }
};
}

#define GAS __attribute__((address_space(1)))
#define LAS __attribute__((address_space(3)))
typedef unsigned short bf16;
typedef unsigned u32x4 __attribute__((ext_vector_type(4)));
typedef unsigned u32x2 __attribute__((ext_vector_type(2)));
typedef float f32x4 __attribute__((ext_vector_type(4)));
typedef short bf16x8 __attribute__((ext_vector_type(8)));
typedef float f32x16 __attribute__((ext_vector_type(16)));
constexpr int SEQ = 8192, DM = 4096, DIN = 7488, ZLD = 7680, DFF = 11008;
constexpr int C_CKV = 768, C_KPE = 1280, C_DQ = 1344, C_DK = 3392, C_DV = 5440;
constexpr float EPS = 1e-6f, LOG2E = 1.4426950408889634f;
constexpr float QSC_MLA = 0.07216878364870323f * LOG2E;
constexpr float QSC_DIFF = 0.08838834764831845f * LOG2E;
constexpr float LAMBDA_INIT = 0.2f;
constexpr int NWAVES = 8;
constexpr int LDS_BYTES = 147456;

constexpr size_t WS_BAR = 0;
constexpr size_t WS_WIN = 16384;
constexpr size_t WS_WUQ = WS_WIN + (size_t)ZLD * DM * 2;
constexpr size_t WS_WUKV = WS_WUQ + (size_t)3072 * 768 * 2;
constexpr size_t WS_WO = WS_WUKV + (size_t)4096 * 512 * 2;
constexpr size_t WS_WGU = WS_WO + (size_t)DM * DM * 2;
constexpr size_t WS_WDN = WS_WGU + (size_t)2 * DFF * DM * 2;
constexpr size_t WS_XN = WS_WDN + (size_t)DM * DFF * 2;
constexpr size_t WS_R1 = WS_XN + (size_t)SEQ * DM * 2;
constexpr size_t WS_Z = WS_R1;
constexpr size_t WS_CQN = WS_Z + (size_t)SEQ * ZLD * 2;
constexpr size_t WS_CKVN = WS_CQN + (size_t)SEQ * 768 * 2;
constexpr size_t WS_QRAW = WS_CKVN + (size_t)SEQ * 512 * 2;
constexpr size_t WS_KVRAW = WS_QRAW + (size_t)SEQ * 3072 * 2;
constexpr size_t WS_R1END = WS_KVRAW + (size_t)SEQ * 4096 * 2;
constexpr size_t WS_QA = WS_R1;
constexpr size_t WS_KA = WS_QA + (size_t)SEQ * 3072 * 2;
constexpr size_t WS_VAT = WS_KA + (size_t)SEQ * 3072 * 2;
static_assert(WS_VAT + (size_t)SEQ * 2048 * 2 <= WS_QRAW, "QA|KA|VAT overlay z|cqn|ckvn only");
constexpr size_t WS_OC = WS_QRAW;
constexpr size_t WS_ACT = WS_R1;
static_assert(WS_ACT + (size_t)SEQ * DFF * 2 <= WS_R1END, "act inside R1");
constexpr size_t WS_QD = WS_R1END;
constexpr size_t WS_KD = WS_QD + (size_t)SEQ * 2048 * 2;
constexpr size_t WS_VDT = WS_KD + (size_t)SEQ * 2048 * 2;
constexpr size_t WS_KPE = WS_VDT + (size_t)SEQ * 2048 * 2;
constexpr size_t WS_ROWSS = WS_KPE + (size_t)SEQ * 64 * 2;
constexpr size_t WS_END = WS_ROWSS + (size_t)SEQ * 4;

struct Args { const float* in[21]; float* out; unsigned char* ws; float invf[64]; int ph_lo, ph_hi; };
static_assert(sizeof(Args) == 21 * 8 + 8 + 8 + 256 + 8, "Args has no padding");

__device__ __forceinline__ float wave_sum(float v) {
#pragma unroll
    for (int o = 1; o < 64; o <<= 1) v += __shfl_xor(v, o);
    return v;
}
__device__ __forceinline__ float bflo(unsigned w) { return __uint_as_float(w << 16); }
__device__ __forceinline__ float bfhi(unsigned w) { return __uint_as_float(w & 0xffff0000u); }
__device__ __forceinline__ void unpack8(const u32x4 a, float (&v)[8]) {
    v[0] = bflo(a.x); v[1] = bfhi(a.x); v[2] = bflo(a.y); v[3] = bfhi(a.y); v[4] = bflo(a.z); v[5] = bfhi(a.z); v[6] = bflo(a.w); v[7] = bfhi(a.w);
}
__device__ __forceinline__ u32x4 pack8(const float (&v)[8]) {
    u32x4 w; w.x = pg8::pk_bf16(v[0], v[1]); w.y = pg8::pk_bf16(v[2], v[3]); w.z = pg8::pk_bf16(v[4], v[5]); w.w = pg8::pk_bf16(v[6], v[7]); return w;
}
__device__ __forceinline__ u32x4 ld16(const bf16* p) { return *(const u32x4*)p; }
__device__ __forceinline__ void st16(bf16* p, u32x4 v) { *(u32x4*)p = v; }
__device__ __forceinline__ void ldg8(const float* g, float (&v)[8]) { const f32x4 a = *(const f32x4*)g, b = *(const f32x4*)(g + 4); v[0] = a.x; v[1] = a.y; v[2] = a.z; v[3] = a.w; v[4] = b.x; v[5] = b.y; v[6] = b.z; v[7] = b.w; }
__device__ __forceinline__ void rope_cs(int pos, float invf, float& c, float& s) {
    const float ang = (float)pos * invf; const double rev = (double)ang * 0.15915494309189535; const float fr = (float)(rev - __builtin_rint(rev));
    c = __builtin_amdgcn_cosf(fr); s = __builtin_amdgcn_sinf(fr);
}

__device__ __forceinline__ void p0_transpose_item(const float* W, int K, int N, bf16* WT, int mode, LAS float* scr, int item, int lane) {
    const int nblk = N / 32, kb = item / nblk, nb = item % nblk, k0 = 64 * kb, n0 = 32 * nb;
    {
        f32x4 t[8]; const int kq = lane >> 3, n4 = (lane & 7) * 4;
#pragma unroll
        for (int i = 0; i < 8; ++i) t[i] = *(const f32x4*)(W + (size_t)(k0 + kq + 8 * i) * N + n0 + n4);
#pragma unroll
        for (int i = 0; i < 8; ++i) { LAS float* d = scr + (kq + 8 * i) * 33 + n4; d[0] = t[i].x; d[1] = t[i].y; d[2] = t[i].z; d[3] = t[i].w; }
    }
    asm volatile("s_waitcnt lgkmcnt(0)" ::: "memory");
    const int c = lane & 7;
    const int rbase = (mode == 0) ? n0 : (((n0 >> 7) << 8) + (n0 & 127) + (mode == 2 ? 128 : 0));
#pragma unroll
    for (int j = 0; j < 4; ++j) { const int n = (lane >> 3) + 8 * j; const LAS float* s = scr + (8 * c) * 33 + n;
        u32x4 o; o.x = pg8::pk_bf16(s[0 * 33], s[1 * 33]); o.y = pg8::pk_bf16(s[2 * 33], s[3 * 33]); o.z = pg8::pk_bf16(s[4 * 33], s[5 * 33]); o.w = pg8::pk_bf16(s[6 * 33], s[7 * 33]);
        *(u32x4*)(WT + (size_t)(rbase + n) * K + k0 + 8 * c) = o; }
    asm volatile("s_waitcnt lgkmcnt(0)" ::: "memory");
}
struct ItemRegs { f32x4 t[8]; };
__device__ __forceinline__ void item_load(ItemRegs& R, const float* W, int N, int item, int lane, const float* gk = nullptr) {
    const int nblk = N / 32, kb = item / nblk, nb = item % nblk, k0 = 64 * kb, n0 = 32 * nb, kq = lane >> 3, n4 = (lane & 7) * 4;
#pragma unroll
    for (int i = 0; i < 8; ++i) { R.t[i] = *(const f32x4*)(W + (size_t)(k0 + kq + 8 * i) * N + n0 + n4); if (gk) R.t[i] = R.t[i] * gk[k0 + kq + 8 * i]; }
}
__device__ __forceinline__ void item_store(const ItemRegs& R, int K, int N, bf16* WT, int mode, LAS float* scr, int item, int lane) {
    const int nblk = N / 32, kb = item / nblk, nb = item % nblk, k0 = 64 * kb, n0 = 32 * nb, kq = lane >> 3, n4 = (lane & 7) * 4;
#pragma unroll
    for (int i = 0; i < 8; ++i) { LAS float* d = scr + (kq + 8 * i) * 33 + n4; d[0] = R.t[i].x; d[1] = R.t[i].y; d[2] = R.t[i].z; d[3] = R.t[i].w; }
    asm volatile("s_waitcnt lgkmcnt(0)" ::: "memory");
    const int c = lane & 7;
    const int rbase = (mode == 0) ? n0 : (((n0 >> 7) << 8) + (n0 & 127) + (mode == 2 ? 128 : 0));
#pragma unroll
    for (int j = 0; j < 4; ++j) { const int n = (lane >> 3) + 8 * j; const LAS float* s = scr + (8 * c) * 33 + n;
        u32x4 o; o.x = pg8::pk_bf16(s[0 * 33], s[1 * 33]); o.y = pg8::pk_bf16(s[2 * 33], s[3 * 33]); o.z = pg8::pk_bf16(s[4 * 33], s[5 * 33]); o.w = pg8::pk_bf16(s[6 * 33], s[7 * 33]);
        *(u32x4*)(WT + (size_t)(rbase + n) * K + k0 + 8 * c) = o; }
    asm volatile("s_waitcnt lgkmcnt(0)" ::: "memory");
}
__device__ __forceinline__ void conv_stream(const float* W, int K, int N, bf16* WT, int mode, LAS float* scr, int begin, int end, int stride, int lane, const float* gk = nullptr) {
    if (begin >= end) return;
    ItemRegs r0, r1, r2; item_load(r0, W, N, begin, lane, gk); if (begin + stride < end) item_load(r1, W, N, begin + stride, lane, gk);
    for (int it = begin; it < end; it += stride) { const int it2 = it + 2 * stride; if (it2 < end) item_load(r2, W, N, it2, lane, gk); item_store(r0, K, N, WT, mode, scr, it, lane); r0 = r1; r1 = r2; }
}
__device__ __forceinline__ void rms_row_4096(const float* xrow, const float* g, bf16* orow, int lane) {
    const f32x4* xr = (const f32x4*)xrow + lane; f32x4 v[16]; float s = 0.f;
#pragma unroll
    for (int j = 0; j < 16; ++j) { v[j] = xr[64 * j]; s += (v[j].x * v[j].x + v[j].y * v[j].y) + (v[j].z * v[j].z + v[j].w * v[j].w); }
    const float rstd = 1.0f / sqrtf(wave_sum(s) * (1.f / 4096.f) + EPS);
    const f32x4* gr = (const f32x4*)g + lane; u32x2* o8 = (u32x2*)orow + lane;
#pragma unroll
    for (int j = 0; j < 16; ++j) { const f32x4 gg = gr[64 * j]; u32x2 w; w.x = pg8::pk_bf16(v[j].x * rstd * gg.x, v[j].y * rstd * gg.y); w.y = pg8::pk_bf16(v[j].z * rstd * gg.z, v[j].w * rstd * gg.w); o8[64 * j] = w; }
}
#define RLX_AGENT __ATOMIC_RELAXED, __HIP_MEMORY_SCOPE_AGENT
#define XB_TMO      128
#define XB_XCNT(j)  (256  + 64 * (j))
#define XB_XSUB(j)  (1280 + 64 * (j))
#define XB_XGEN(j)  (2304 + 64 * (j))
#define XB_TOP      3328
#define XB_TOPGEN   3392
#define XCD_BAR_WORDS 3456
#define XB_SPIN_CAP (1u << 18)

__device__ __forceinline__ unsigned xb_ld(unsigned* p)              { return __hip_atomic_load(p, __ATOMIC_RELAXED, __HIP_MEMORY_SCOPE_AGENT); }
__device__ __forceinline__ unsigned xb_add(unsigned* p, unsigned v) { return __hip_atomic_fetch_add(p, v, __ATOMIC_RELAXED, __HIP_MEMORY_SCOPE_AGENT); }
__device__ __forceinline__ unsigned xb_xcc_id() { return (unsigned)__builtin_amdgcn_s_getreg((3 << 11) | 20) & 0xFu; }
#define XB_SPIN(cond, bar) do { unsigned _sp = 0; while (cond) { __builtin_amdgcn_s_sleep(1); \
    if ((++_sp & 255u) == 0u) { if (xb_ld(&(bar)[XB_TMO])) break; if (_sp > XB_SPIN_CAP) { atomicAdd(&(bar)[XB_TMO], 1u); break; } } } } while (0)

struct XcdBarrier {
    unsigned* bar; unsigned x;
    volatile LAS unsigned* st;
};

__device__ __forceinline__ XcdBarrier xcd_barrier_post(unsigned* bar, volatile LAS unsigned* st, bool t0) {
    XcdBarrier b; b.bar = bar; b.x = xb_xcc_id(); b.st = st;
    if (t0) (void)xb_add(&bar[XB_XCNT(b.x)], 1u);
    return b;
}
__device__ __forceinline__ void xcd_barrier_complete(unsigned* bar, unsigned x, unsigned& nloc, unsigned& nx) {
    const unsigned G = gridDim.x * gridDim.y * gridDim.z;
    unsigned sum, cnt, mine, sp = 0u;
    for (;;) {
        sum = 0u; cnt = 0u; mine = 0u;
#pragma unroll
        for (unsigned j = 0; j < 16; ++j) { const unsigned c = xb_ld(&bar[XB_XCNT(j)]); sum += c; cnt += (c > 0u) ? 1u : 0u; mine = (j == x) ? c : mine; }
        if (sum == G) break;
        __builtin_amdgcn_s_sleep(1);
        if ((++sp & 255u) == 0u) { if (xb_ld(&bar[XB_TMO])) break; if (sp > XB_SPIN_CAP) { atomicAdd(&bar[XB_TMO], 1u); break; } }
    }
    nloc = mine > 0u ? mine : 1u; nx = cnt > 0u ? cnt : 1u;
}

__device__ __forceinline__ void xcd_barrier(const XcdBarrier& b, bool t0) {
    asm volatile("s_waitcnt vmcnt(0)" ::: "memory");
    __syncthreads();
    if (t0) {
        unsigned* bar = b.bar;
        __builtin_amdgcn_s_waitcnt(0);
        unsigned nloc = b.st[0], nx = b.st[1];
        if (nloc == 0u) { xcd_barrier_complete(bar, b.x, nloc, nx); b.st[0] = nloc; b.st[1] = nx; }
        const unsigned old = xb_add(&bar[XB_XSUB(b.x)], 1u);
        const unsigned gen = old / nloc;
        if (old + 1u == (gen + 1u) * nloc) {
            __builtin_amdgcn_fence(__ATOMIC_RELEASE, "agent");
            asm volatile("s_waitcnt vmcnt(0)" ::: "memory");
            const unsigned og = xb_add(&bar[XB_TOP], 1u);
            const unsigned tg = og / nx;
            if (og + 1u == (tg + 1u) * nx) xb_add(&bar[XB_TOPGEN], 1u);
            else XB_SPIN(xb_ld(&bar[XB_TOPGEN]) == tg, bar);
            __builtin_amdgcn_fence(__ATOMIC_ACQUIRE, "agent");
            xb_add(&bar[XB_XGEN(b.x)], 1u);
            asm volatile("s_waitcnt vmcnt(0)" ::: "memory");
        } else {
            XB_SPIN(xb_ld(&bar[XB_XGEN(b.x)]) == gen, bar);
            __builtin_amdgcn_fence(__ATOMIC_ACQUIRE, "agent");
            asm volatile("s_waitcnt vmcnt(0)" ::: "memory");
        }
    }
    __syncthreads();
}

constexpr int TP_PITCH = 1040;
__device__ __forceinline__ void tp_store(LAS const unsigned char* tl, bf16* dst, int s0, int tid) {
#pragma unroll
    for (int k = 0; k < 4; ++k) { const int idx = tid + 512 * k, sg = idx & 3, col = idx >> 2; const LAS unsigned char* p = tl + (8 * sg) * TP_PITCH + 2 * col;
        unsigned short e[8];
#pragma unroll
        for (int i = 0; i < 8; ++i) e[i] = *(const LAS unsigned short*)(p + i * TP_PITCH);
        u32x4 w; w.x = e[0] | ((unsigned)e[1] << 16); w.y = e[2] | ((unsigned)e[3] << 16); w.z = e[4] | ((unsigned)e[5] << 16); w.w = e[6] | ((unsigned)e[7] << 16);
        st16(dst + (size_t)col * SEQ + s0 + 8 * sg, w); }
}

struct P2Row { u32x4 cq0, cq1, ckv, kpe, dq[4], dk[4]; };
__device__ __forceinline__ void p2_load(P2Row& R, const bf16* zr, int lane) {
    const u32x4 z4 = {0u, 0u, 0u, 0u}; const int sub = lane & 15;
    R.cq0 = ld16(zr + 8 * lane); R.cq1 = (lane < 32) ? ld16(zr + 512 + 8 * lane) : z4; R.ckv = ld16(zr + C_CKV + 8 * lane); R.kpe = (lane < 8) ? ld16(zr + C_KPE + 8 * lane) : z4;
#pragma unroll
    for (int rd = 0; rd < 4; ++rd) { const int head = rd * 4 + (lane >> 4); R.dq[rd] = ld16(zr + C_DQ + head * 128 + sub * 8); R.dk[rd] = ld16(zr + C_DK + head * 128 + sub * 8); }
}
__device__ __forceinline__ void p2_phase(const Args& A, LAS unsigned char* lds, int vcu, int G, int tid, int wave, int lane) {
    unsigned char* ws = A.ws;
    const bf16* Z = (const bf16*)(ws + WS_Z); bf16* CQN = (bf16*)(ws + WS_CQN); bf16* CKVN = (bf16*)(ws + WS_CKVN); bf16* KPE = (bf16*)(ws + WS_KPE);
    bf16* QD = (bf16*)(ws + WS_QD); bf16* KD = (bf16*)(ws + WS_KD); bf16* VDT = (bf16*)(ws + WS_VDT);
    const int sub = lane & 15;
    float gq0[8], gq1[8], gkv[8], gdq[8], gdk[8];
    ldg8(A.in[3] + 8 * lane, gq0); ldg8(A.in[3] + 512 + 8 * (lane & 31), gq1); ldg8(A.in[4] + 8 * lane, gkv); ldg8(A.in[9] + 8 * sub, gdq); ldg8(A.in[10] + 8 * sub, gdk);
    float ifr[8];
#pragma unroll
    for (int e = 0; e < 8; ++e) ifr[e] = A.invf[8 * (sub & 7) + e];
    for (int unit = vcu; unit < SEQ / 32; unit += G) {
        const int s0 = unit * 32;
        P2Row cur, nxt;
        p2_load(cur, Z + (size_t)(s0 + wave * 4) * ZLD, lane);
#pragma unroll
        for (int i = 0; i < 4; ++i) {
            const int row = s0 + wave * 4 + i;
            if (i < 3) p2_load(nxt, Z + (size_t)(row + 1) * ZLD, lane);
            {
                float va[8], vb[8]; unpack8(cur.cq0, va); unpack8(cur.cq1, vb); float ss = 0.f;
#pragma unroll
                for (int e = 0; e < 8; ++e) ss += va[e] * va[e] + vb[e] * vb[e];
                const float rstd = 1.0f / sqrtf(wave_sum(ss) * (1.f / 768.f) + EPS);
#pragma unroll
                for (int e = 0; e < 8; ++e) { va[e] = va[e] * rstd * gq0[e]; vb[e] = vb[e] * rstd * gq1[e]; }
                st16(CQN + (size_t)row * 768 + 8 * lane, pack8(va));
                if (lane < 32) st16(CQN + (size_t)row * 768 + 512 + 8 * lane, pack8(vb));
            }
            {
                float va[8]; unpack8(cur.ckv, va); float ss = 0.f;
#pragma unroll
                for (int e = 0; e < 8; ++e) ss += va[e] * va[e];
                const float rstd = 1.0f / sqrtf(wave_sum(ss) * (1.f / 512.f) + EPS);
#pragma unroll
                for (int e = 0; e < 8; ++e) va[e] = va[e] * rstd * gkv[e];
                st16(CKVN + (size_t)row * 512 + 8 * lane, pack8(va));
            }
            if (lane < 8) st16(KPE + (size_t)row * 64 + 8 * lane, cur.kpe);
            float cs[8], sn[8];
#pragma unroll
            for (int e = 0; e < 8; ++e) rope_cs(row, ifr[e], cs[e], sn[e]);
#pragma unroll
            for (int which = 0; which < 2; ++which) {
                bf16* dst = which ? KD : QD; const float osc = which ? 1.0f : QSC_DIFF;
#pragma unroll
                for (int rd = 0; rd < 4; ++rd) {
                    const int head = rd * 4 + (lane >> 4);
                    float v[8]; unpack8(which ? cur.dk[rd] : cur.dq[rd], v); float ss = 0.f;
#pragma unroll
                    for (int e = 0; e < 8; ++e) ss += v[e] * v[e];
                    ss += __shfl_xor(ss, 1); ss += __shfl_xor(ss, 2); ss += __shfl_xor(ss, 4); ss += __shfl_xor(ss, 8);
                    const float rstd = 1.0f / sqrtf(ss * (1.f / 128.f) + EPS);
                    float o[8];
#pragma unroll
                    for (int e = 0; e < 8; ++e) { const float y = v[e] * rstd * (which ? gdk[e] : gdq[e]); const float p = __shfl_xor(y, 8); o[e] = ((sub < 8) ? (y * cs[e] - p * sn[e]) : (y * cs[e] + p * sn[e])) * osc; }
                    st16(dst + (size_t)row * 2048 + head * 128 + sub * 8, pack8(o));
                }
            }
            cur = nxt;
        }
        for (int pass = 0; pass < 4; ++pass) {
            __syncthreads();
#pragma unroll
            for (int k = 0; k < 4; ++k) { const int idx = tid + 512 * k, r = idx >> 6, c = idx & 63;
                *(LAS u32x4*)(lds + r * TP_PITCH + 16 * c) = ld16(Z + (size_t)(s0 + r) * ZLD + C_DV + 512 * pass + 8 * c); }
            __syncthreads();
            tp_store(lds, VDT + (size_t)(512 * pass) * SEQ, s0, tid);
        }
        __syncthreads();
    }
}

struct P4Row { u32x4 q[8], k[8]; };
__device__ __forceinline__ void p4_load(P4Row& R, const bf16* QRAW, const bf16* KVRAW, const bf16* KPE, int row, int lane) {
    const u32x4 z4 = {0u, 0u, 0u, 0u}; const int sub = lane & 31, hsel = lane >> 5; const bool act = sub < 24;
    const u32x4 kpe = (sub >= 16 && act) ? ld16(KPE + (size_t)row * 64 + (sub - 16) * 8) : z4;
#pragma unroll
    for (int rd = 0; rd < 8; ++rd) { const int head = 2 * rd + hsel;
        R.q[rd] = act ? ld16(QRAW + (size_t)row * 3072 + head * 192 + sub * 8) : z4;
        R.k[rd] = (sub < 16) ? ld16(KVRAW + (size_t)row * 4096 + head * 256 + sub * 8) : kpe; }
}
__device__ __forceinline__ void p4_phase(const Args& A, LAS unsigned char* lds, int vcu, int G, int tid, int wave, int lane) {
    unsigned char* ws = A.ws;
    const bf16* QRAW = (const bf16*)(ws + WS_QRAW); const bf16* KVRAW = (const bf16*)(ws + WS_KVRAW); const bf16* KPE = (const bf16*)(ws + WS_KPE);
    bf16* QA = (bf16*)(ws + WS_QA); bf16* KA = (bf16*)(ws + WS_KA); bf16* VAT = (bf16*)(ws + WS_VAT);
    const int sub = lane & 31, hsel = lane >> 5; const bool act = sub < 24; const int subc = act ? sub : 0;
    const bool rlo = (sub >= 16 && sub < 20), rhi = (sub >= 20 && sub < 24);
    float gq[8], gk[8]; ldg8(A.in[7] + 8 * subc, gq); ldg8(A.in[8] + 8 * subc, gk);
    float ifr[8];
#pragma unroll
    for (int e = 0; e < 8; ++e) ifr[e] = A.invf[2 * (8 * (sub & 3) + e)];
    for (int unit = vcu; unit < SEQ / 32; unit += G) {
        const int s0 = unit * 32;
        for (int i = 0; i < 4; ++i) {
            const int row = s0 + wave * 4 + i;
            P4Row cur; { int lo_ = lane; asm volatile("" : "+v"(lo_)); p4_load(cur, QRAW, KVRAW, KPE, row, lo_); }
            float cs[8], sn[8];
#pragma unroll
            for (int e = 0; e < 8; ++e) rope_cs(row, ifr[e], cs[e], sn[e]);
#pragma unroll
            for (int which = 0; which < 2; ++which) {
                bf16* dst = which ? KA : QA; const float osc = which ? 1.0f : QSC_MLA;
#pragma unroll
                for (int rd = 0; rd < 8; ++rd) {
                    const int head = 2 * rd + hsel;
                    float v[8]; unpack8(which ? cur.k[rd] : cur.q[rd], v); float ss = 0.f;
#pragma unroll
                    for (int e = 0; e < 8; ++e) ss += v[e] * v[e];
                    ss += __shfl_xor(ss, 1); ss += __shfl_xor(ss, 2); ss += __shfl_xor(ss, 4); ss += __shfl_xor(ss, 8); ss += __shfl_xor(ss, 16);
                    const float rstd = 1.0f / sqrtf(ss * (1.f / 192.f) + EPS);
                    float o[8];
#pragma unroll
                    for (int e = 0; e < 8; ++e) { const float y = v[e] * rstd * (which ? gk[e] : gq[e]); const float p = __shfl_xor(y, 4);
                        float r = y; if (rlo) r = y * cs[e] - p * sn[e]; if (rhi) r = y * cs[e] + p * sn[e]; o[e] = r * osc; }
                    if (act) st16(dst + (size_t)row * 3072 + head * 192 + sub * 8, pack8(o));
                }
            }
        }
        for (int pass = 0; pass < 4; ++pass) {
            __syncthreads();
#pragma unroll
            for (int k = 0; k < 4; ++k) { const int idx = tid + 512 * k, r = idx >> 6, c = idx & 63, hl = c >> 4, cc = c & 15;
                *(LAS u32x4*)(lds + r * TP_PITCH + 16 * c) = ld16(KVRAW + (size_t)(s0 + r) * 4096 + (4 * pass + hl) * 256 + 128 + 8 * cc); }
            __syncthreads();
            tp_store(lds, VAT + (size_t)(512 * pass) * SEQ, s0, tid);
        }
        __syncthreads();
    }
}

namespace att {
__device__ __forceinline__ int swap23(int i) { return (i & ~12) | ((i & 4) << 1) | ((i & 8) >> 1); }
__device__ __forceinline__ void glds16(const void* gsrc, unsigned lds_dst) { unsigned keep;
    asm volatile("s_mov_b32 %0, m0\n\ts_mov_b32 m0, %2\n\ts_nop 0\n\tglobal_load_lds_dwordx4 %1, off\n\ts_mov_b32 m0, %0" : "=&s"(keep) : "v"(gsrc), "s"(lds_dst) : "memory"); }
#define ATT_WAIT_BAR() asm volatile("s_waitcnt vmcnt(0) lgkmcnt(0)\n\ts_barrier" ::: "memory")
__device__ __forceinline__ int crow(int r, int hi) { return (r & 3) + 8 * (r >> 2) + 4 * hi; }

#define ATT_SB() do { asm volatile("" ::: "memory"); __builtin_amdgcn_sched_barrier(0); } while (0)
template <int ND_A, int ND_B>
__device__ __forceinline__ bf16x8 frag_load(const LAS unsigned char* kA, const LAS unsigned char* kB, const LAS unsigned char* vt, int e, int kb, int r32, int xk, int xv) {
    constexpr int ND = ND_A + ND_B;
    if (e < ND_A) return *(const LAS bf16x8*)(kA + (32 * kb + r32) * 256 + (((2 * e) ^ xk) << 4));
    if (e < ND) return *(const LAS bf16x8*)(kB + (32 * kb + r32) * 128 + (((2 * (e - ND_A)) ^ xv) << 4));
    const int db = (e - ND) >> 1, ss = (e - ND) & 1;
    return *(const LAS bf16x8*)(vt + (32 * db + r32) * 128 + (((4 * kb + 2 * ss) ^ xv) << 4));
}
template <int ND_A, int ND_B, int NDB, int PD>
__device__ __forceinline__ void tile_compute(const bf16x8 (&fpre)[PD], const LAS unsigned char* kA, const LAS unsigned char* kB, const LAS unsigned char* vt, const bf16x8* qf, f32x16* o, float& lsum, int r32, int hi) {
    constexpr int ND = ND_A + ND_B, TOT = ND + 2 * NDB;
    bf16x8 f[2][TOT + PD];
#pragma unroll
    for (int i = 0; i < PD; ++i) f[0][i] = fpre[i];
    const int r32in = r32;
#pragma unroll
    for (int kb = 0; kb < 2; ++kb) {
        int r32 = r32in; asm volatile("" : "+v"(r32));
        const int xk = (r32 & 15) ^ hi, xv = ((r32 >> 1) & 7) ^ hi;
        f32x16 s = {0.f, 0.f, 0.f, 0.f, 0.f, 0.f, 0.f, 0.f, 0.f, 0.f, 0.f, 0.f, 0.f, 0.f, 0.f, 0.f};
#pragma unroll
        for (int e = 0; e < ND; ++e) {
            f[kb][e + PD] = frag_load<ND_A, ND_B>(kA, kB, vt, e + PD, kb, r32, xk, xv);
            s = __builtin_amdgcn_mfma_f32_32x32x16_bf16(f[kb][e], qf[e], s, 0, 0, 0);
            ATT_SB();
        }
        float la = 0.f, lb = 0.f; u32x4 w0, w1;
        { const float p0 = __builtin_amdgcn_exp2f(s[0]), p1 = __builtin_amdgcn_exp2f(s[1]), p2 = __builtin_amdgcn_exp2f(s[2]), p3 = __builtin_amdgcn_exp2f(s[3]); la += p0 + p2; lb += p1 + p3; w0.x = pg8::pk_bf16(p0, p1); w0.y = pg8::pk_bf16(p2, p3); }
        { const float p0 = __builtin_amdgcn_exp2f(s[4]), p1 = __builtin_amdgcn_exp2f(s[5]), p2 = __builtin_amdgcn_exp2f(s[6]), p3 = __builtin_amdgcn_exp2f(s[7]); la += p0 + p2; lb += p1 + p3; w0.z = pg8::pk_bf16(p0, p1); w0.w = pg8::pk_bf16(p2, p3); }
        { const float p0 = __builtin_amdgcn_exp2f(s[8]), p1 = __builtin_amdgcn_exp2f(s[9]), p2 = __builtin_amdgcn_exp2f(s[10]), p3 = __builtin_amdgcn_exp2f(s[11]); la += p0 + p2; lb += p1 + p3; w1.x = pg8::pk_bf16(p0, p1); w1.y = pg8::pk_bf16(p2, p3); }
        { const float p0 = __builtin_amdgcn_exp2f(s[12]), p1 = __builtin_amdgcn_exp2f(s[13]), p2 = __builtin_amdgcn_exp2f(s[14]), p3 = __builtin_amdgcn_exp2f(s[15]); la += p0 + p2; lb += p1 + p3; w1.z = pg8::pk_bf16(p0, p1); w1.w = pg8::pk_bf16(p2, p3); }
        lsum += la + lb;
        const bf16x8 pb0 = __builtin_bit_cast(bf16x8, w0), pb1 = __builtin_bit_cast(bf16x8, w1);
        ATT_SB();
#pragma unroll
        for (int e = ND; e < TOT; ++e) {
            if (e + PD < TOT) f[kb][e + PD] = frag_load<ND_A, ND_B>(kA, kB, vt, e + PD, kb, r32, xk, xv);
            else if (kb == 0) f[1][e + PD - TOT] = frag_load<ND_A, ND_B>(kA, kB, vt, e + PD - TOT, 1, r32, xk, xv);
            const int db = (e - ND) >> 1;
            o[db] = __builtin_amdgcn_mfma_f32_32x32x16_bf16(f[kb][e], ((e - ND) & 1) ? pb1 : pb0, o[db], 0, 0, 0);
            ATT_SB();
        }
    }
}

template <int ND_A, int ND_B, int NDB>
__device__ __forceinline__ void tile_compute_simple(const LAS unsigned char* kA, const LAS unsigned char* kB, const LAS unsigned char* vt, const bf16x8* qf, f32x16* o, float& lsum, int r32, int hi) {
    static_assert(ND_B == 0, "simple form: one K region");
    const int xk = (r32 & 15) ^ hi, xv = ((r32 >> 1) & 7) ^ hi;
#pragma unroll
    for (int kb = 0; kb < 2; ++kb) {
        f32x16 s = {0.f, 0.f, 0.f, 0.f, 0.f, 0.f, 0.f, 0.f, 0.f, 0.f, 0.f, 0.f, 0.f, 0.f, 0.f, 0.f};
        const LAS unsigned char* ka = kA + (32 * kb + r32) * 256;
        bf16x8 a = *(const LAS bf16x8*)(ka + ((0 ^ xk) << 4));
#pragma unroll
        for (int d0 = 0; d0 < ND_A; ++d0) { bf16x8 an = a; if (d0 + 1 < ND_A) an = *(const LAS bf16x8*)(ka + (((2 * (d0 + 1)) ^ xk) << 4));
            s = __builtin_amdgcn_mfma_f32_32x32x16_bf16(a, qf[d0], s, 0, 0, 0); a = an; __builtin_amdgcn_sched_barrier(0); }
        const LAS unsigned char* vr = vt + r32 * 128;
        bf16x8 v0 = *(const LAS bf16x8*)(vr + (((4 * kb) ^ xv) << 4)), v1 = *(const LAS bf16x8*)(vr + (((4 * kb + 2) ^ xv) << 4));
        float p[16];
#pragma unroll
        for (int r = 0; r < 16; ++r) { p[r] = __builtin_amdgcn_exp2f(s[r]); lsum += p[r]; }
        u32x4 w0, w1; w0.x = pg8::pk_bf16(p[0], p[1]); w0.y = pg8::pk_bf16(p[2], p[3]); w0.z = pg8::pk_bf16(p[4], p[5]); w0.w = pg8::pk_bf16(p[6], p[7]);
        w1.x = pg8::pk_bf16(p[8], p[9]); w1.y = pg8::pk_bf16(p[10], p[11]); w1.z = pg8::pk_bf16(p[12], p[13]); w1.w = pg8::pk_bf16(p[14], p[15]);
        const bf16x8 pb0 = __builtin_bit_cast(bf16x8, w0), pb1 = __builtin_bit_cast(bf16x8, w1);
        __builtin_amdgcn_sched_barrier(0);
#pragma unroll
        for (int db = 0; db < NDB; ++db) { bf16x8 n0 = v0, n1 = v1;
            if (db + 1 < NDB) { n0 = *(const LAS bf16x8*)(vr + (db + 1) * 4096 + (((4 * kb) ^ xv) << 4)); n1 = *(const LAS bf16x8*)(vr + (db + 1) * 4096 + (((4 * kb + 2) ^ xv) << 4)); }
            o[db] = __builtin_amdgcn_mfma_f32_32x32x16_bf16(v0, pb0, o[db], 0, 0, 0); o[db] = __builtin_amdgcn_mfma_f32_32x32x16_bf16(v1, pb1, o[db], 0, 0, 0); v0 = n0; v1 = n1; __builtin_amdgcn_sched_barrier(0); }
    }
}

constexpr int MLA_STAGE = 40960, DIFF_STAGE = 65536;
#ifndef DIFF_PD
#define DIFF_PD 0
#endif
__device__ __forceinline__ void glds16s(unsigned voff, const void* sbase, unsigned lds_dst) { unsigned keep;
    asm volatile("s_nop 3\n\ts_mov_b32 %0, m0\n\ts_mov_b32 m0, %3\n\ts_nop 0\n\tglobal_load_lds_dwordx4 %1, %2\n\ts_mov_b32 m0, %0" : "=&s"(keep) : "v"(voff), "s"(sbase), "s"(lds_dst) : "memory"); }
__device__ __forceinline__ void mla_stage(const char* Kb, const char* Vb, int t, unsigned dst, int wave, int lane) {
    asm volatile("" : "+v"(lane));
    const unsigned q = lane >> 4, g3 = lane >> 3;
    const unsigned Bn = ((lane & 15) ^ q) * 16, Br = ((lane & 7) ^ q) * 16;
    const int w0 = wave & 1, w1 = (wave >> 1) & 1, w2 = wave >> 2;
    const char* kbase = Kb + (size_t)(64 * t + 32 * w2 + 16 * w1 + 4 * w0) * 6144;
#pragma unroll
    for (int j = 0; j < 2; ++j)
        glds16s(q * 6144 + (Bn ^ (unsigned)(128 * w0 + 64 * j)), kbase + (size_t)(8 * j) * 6144, (unsigned)__builtin_amdgcn_readfirstlane(dst + (2 * wave + j) * 1024));
    glds16s((8 * (lane >> 5) + (g3 & 3)) * 6144 + (Br ^ (unsigned)(64 * w0)), kbase + 256, (unsigned)__builtin_amdgcn_readfirstlane(dst + 16384 + wave * 1024));
    const char* vbase = Vb + (size_t)(2 * wave) * 8 * (SEQ * 2) + t * 128;
#pragma unroll
    for (int j = 0; j < 2; ++j)
        glds16s(g3 * (SEQ * 2) + (Br ^ (unsigned)(64 * j)), vbase + (size_t)j * 8 * (SEQ * 2), (unsigned)__builtin_amdgcn_readfirstlane(dst + 24576 + (2 * wave + j) * 1024));
}
__device__ __forceinline__ void diff_stage(const char* Kb, const char* Vb, int t, unsigned dst, int wave, int lane) {
    asm volatile("" : "+v"(lane));
    const unsigned q = lane >> 4;
    if (wave < 4) {
        const unsigned A = q * 4096, B = ((lane & 15) ^ q) * 16;
        const char* base = Kb + (wave >> 1) * 256 + (size_t)(64 * t + 32 * (wave & 1)) * 4096;
#pragma unroll
        for (int k = 0; k < 8; ++k) { const int Kk = 16 * (k >> 2) + 8 * (k & 1) + 4 * ((k >> 1) & 1);
            glds16s(A + (B ^ (unsigned)(64 * (k & 3))), base + (size_t)Kk * 4096, (unsigned)__builtin_amdgcn_readfirstlane(dst + (wave * 8 + k) * 1024)); }
    } else {
        const unsigned A = (lane >> 3) * (SEQ * 2), B = ((lane & 7) ^ q) * 16;
        const char* base = Vb + (size_t)(wave - 4) * 64 * (SEQ * 2) + t * 128;
#pragma unroll
        for (int k = 0; k < 8; ++k)
            glds16s(A + (B ^ (unsigned)(64 * (k & 1))), base + (size_t)k * 8 * (SEQ * 2), (unsigned)__builtin_amdgcn_readfirstlane(dst + (wave * 8 + k) * 1024));
    }
}

__device__ __forceinline__ void mla_unit(int h, int qb, const bf16* QA, const bf16* KA, const bf16* VAT, bf16* OC, LAS unsigned char* lds, int wave, int lane) {
    const int r32 = lane & 31, hi = lane >> 5; const unsigned lds0 = (unsigned)(uintptr_t)lds;
    const int row = 256 * qb + 32 * wave + r32, cw = 4 * qb + (wave >> 1), NT = 4 * qb + 4;
    const char* Kb = (const char*)(KA + h * 192); const char* Vb = (const char*)(VAT + (size_t)h * 128 * SEQ);
    mla_stage(Kb, Vb, 0, lds0, wave, lane);
    bf16x8 qf[12];
#pragma unroll
    for (int d0 = 0; d0 < 12; ++d0) qf[d0] = *(const bf16x8*)(QA + (size_t)row * 3072 + h * 192 + 16 * d0 + 8 * hi);
#pragma unroll
    for (int d0 = 0; d0 < 12; ++d0) asm volatile("" : "+v"(qf[d0]));
    f32x16 o[4];
#pragma unroll
    for (int db = 0; db < 4; ++db)
#pragma unroll
        for (int r = 0; r < 16; ++r) o[db][r] = 0.f;
    float lsum = 0.f;
    for (int t = 0; t < NT; ++t) {
        ATT_WAIT_BAR();
        const LAS unsigned char* sb = lds + (t & 1) * MLA_STAGE; int r32o = r32; asm volatile("" : "+v"(r32o));
        bf16x8 fp[2];
        if (t <= cw) { fp[0] = frag_load<8, 4>(sb, sb + 16384, sb + 24576, 0, 0, r32o, (r32o & 15) ^ hi, ((r32o >> 1) & 7) ^ hi); fp[1] = frag_load<8, 4>(sb, sb + 16384, sb + 24576, 1, 0, r32o, (r32o & 15) ^ hi, ((r32o >> 1) & 7) ^ hi); }
        if (t + 1 < NT) mla_stage(Kb, Vb, t + 1, lds0 + ((t + 1) & 1) * MLA_STAGE, wave, lane);
        if (t <= cw) tile_compute<8, 4, 4, 2>(fp, sb, sb + 16384, sb + 24576, qf, o, lsum, r32o, hi);
    }
    lsum += __shfl_xor(lsum, 32);
    const float inv = 1.0f / lsum;
    bf16* orow = OC + (size_t)row * 4096 + h * 128;
#pragma unroll
    for (int db = 0; db < 4; ++db)
#pragma unroll
        for (int g4 = 0; g4 < 4; ++g4) { u32x2 w; w.x = pg8::pk_bf16(o[db][4 * g4] * inv, o[db][4 * g4 + 1] * inv); w.y = pg8::pk_bf16(o[db][4 * g4 + 2] * inv, o[db][4 * g4 + 3] * inv);
            *(u32x2*)(orow + 32 * db + 8 * g4 + 4 * hi) = w; }
    ATT_WAIT_BAR();
}

__device__ __forceinline__ void diff_unit(int h, int j, float lam, const bf16* QD, const bf16* KD, const bf16* VDT, const float* gsub, bf16* OC, LAS unsigned char* lds, int wave, int lane) {
    const int r32 = lane & 31, hi = lane >> 5, m = wave >> 2, qs = wave & 3; const unsigned lds0 = (unsigned)(uintptr_t)lds;
    const int row = 128 * j + 32 * qs + r32, cw = 2 * j + (qs >> 1), NT = 2 * j + 2;
    const char* Kb = (const char*)(KD + (h * 2) * 128); const char* Vb = (const char*)(VDT + (size_t)h * 256 * SEQ);
    diff_stage(Kb, Vb, 0, lds0, wave, lane);
    bf16x8 qf[8];
#pragma unroll
    for (int d0 = 0; d0 < 8; ++d0) qf[d0] = *(const bf16x8*)(QD + (size_t)row * 2048 + (h * 2 + m) * 128 + 16 * d0 + 8 * hi);
#pragma unroll
    for (int d0 = 0; d0 < 8; ++d0) asm volatile("" : "+v"(qf[d0]));
    f32x16 o[8];
#pragma unroll
    for (int db = 0; db < 8; ++db)
#pragma unroll
        for (int r = 0; r < 16; ++r) o[db][r] = 0.f;
    float lsum = 0.f;
    for (int t = 0; t < NT; ++t) {
        ATT_WAIT_BAR();
        const LAS unsigned char* sb = lds + (t & 1) * DIFF_STAGE; int r32o = r32; asm volatile("" : "+v"(r32o));
#if DIFF_PD == 0
        if (t + 1 < NT) diff_stage(Kb, Vb, t + 1, lds0 + ((t + 1) & 1) * DIFF_STAGE, wave, lane);
        if (t <= cw) tile_compute_simple<8, 0, 8>(sb + m * 16384, sb, sb + 32768, qf, o, lsum, r32o, hi);
#else
        bf16x8 fp[DIFF_PD];
        if (t <= cw) {
#pragma unroll
            for (int i = 0; i < DIFF_PD; ++i) fp[i] = frag_load<8, 0>(sb + m * 16384, sb, sb + 32768, i, 0, r32o, (r32o & 15) ^ hi, ((r32o >> 1) & 7) ^ hi); }
        if (t + 1 < NT) diff_stage(Kb, Vb, t + 1, lds0 + ((t + 1) & 1) * DIFF_STAGE, wave, lane);
        if (t <= cw) tile_compute<8, 0, 8, DIFF_PD>(fp, sb + m * 16384, sb, sb + 32768, qf, o, lsum, r32o, hi);
#endif
    }
    lsum += __shfl_xor(lsum, 32);
    ATT_WAIT_BAR();
    LAS float* X = (LAS float*)lds;
    if (m == 1) { const float f = lam / lsum;
#pragma unroll
        for (int db = 0; db < 8; ++db)
#pragma unroll
            for (int r = 0; r < 16; ++r) X[(32 * db + crow(r, hi)) * 128 + 32 * qs + r32] = o[db][r] * f; }
    ATT_WAIT_BAR();
    if (m == 0) { const float inv = 1.0f / lsum; float ss = 0.f;
#pragma unroll
        for (int db = 0; db < 8; ++db)
#pragma unroll
            for (int r = 0; r < 16; ++r) { const float v = o[db][r] * inv - X[(32 * db + crow(r, hi)) * 128 + 32 * qs + r32]; o[db][r] = v; ss += v * v; }
        ss += __shfl_xor(ss, 32);
        const float sc = (1.0f - LAMBDA_INIT) / sqrtf(ss * (1.f / 256.f) + EPS);
        bf16* orow = OC + (size_t)row * 4096 + 2048 + h * 256;
#pragma unroll
        for (int db = 0; db < 8; ++db)
#pragma unroll
            for (int g4 = 0; g4 < 4; ++g4) { const int dv0 = 32 * db + 8 * g4 + 4 * hi; const f32x4 g = *(const f32x4*)(gsub + dv0);
                u32x2 w; w.x = pg8::pk_bf16(o[db][4 * g4] * sc * g.x, o[db][4 * g4 + 1] * sc * g.y); w.y = pg8::pk_bf16(o[db][4 * g4 + 2] * sc * g.z, o[db][4 * g4 + 3] * sc * g.w);
                *(u32x2*)(orow + dv0) = w; } }
    ATT_WAIT_BAR();
}
}

__device__ __forceinline__ int fresh_lane() { int l = (int)__builtin_amdgcn_mbcnt_hi(~0u, __builtin_amdgcn_mbcnt_lo(~0u, 0u)); asm volatile("" : "+v"(l)); return l; }
constexpr int I_IN = (DM / 64) * (DIN / 32), I_UQ = (768 / 64) * (3072 / 32), I_UKV = (512 / 64) * (4096 / 32), I_O = (DM / 64) * (DM / 32), I_G = (DM / 64) * (DFF / 32), I_D = (DFF / 64) * (DM / 32);
constexpr int NG1 = 13000, ND8 = 19000, NU3 = 8000, SPARE1 = 16, SPARE8 = 5;
static_assert(NG1 <= I_G && ND8 <= I_D, "deferred item counts");
__global__ void __launch_bounds__(NWAVES * 64) fwd_kernel(Args A) {
    extern __shared__ __attribute__((aligned(16))) unsigned char lds_raw[];
    LAS unsigned char* lds = (LAS unsigned char*)lds_raw;
    cg::grid_group grid = cg::this_grid();
    const int wave = __builtin_amdgcn_readfirstlane((int)threadIdx.x >> 6);
    const int lane = (int)__builtin_amdgcn_mbcnt_hi(~0u, __builtin_amdgcn_mbcnt_lo(~0u, 0u)), tid = wave * 64 + lane;
    const int G = gridDim.x, bx = blockIdx.x; const int vcu = (G % 8 == 0) ? (bx % 8) * (G / 8) + bx / 8 : bx;
    unsigned char* ws = A.ws;
    const int lo = A.ph_lo, hi = A.ph_hi;
#define IN(k) (lo <= (k) && (k) < hi)
#ifndef PROBE_MASK
#define PROBE_MASK 0
#endif
#define REPS(k) for (int rep_ = 0; rep_ < (((PROBE_MASK >> (k)) & 1) ? 2 : 1); ++rep_)
    volatile LAS unsigned* bst = (volatile LAS unsigned*)(lds + LDS_BYTES - 64);
    if (tid < 2) bst[tid] = 0u;
    __syncthreads();
    XcdBarrier bar; bar.bar = (unsigned*)(ws + WS_BAR); bar.x = 0; bar.st = bst;
    const bool t0 = (tid == 0);
    if (hi - lo > 1) bar = xcd_barrier_post((unsigned*)(ws + WS_BAR), bst, t0);
#define SEAM(k) do { if (IN(k) && IN((k) + 1)) { if ((k) == 0) grid.sync(); else xcd_barrier(bar, t0); } } while (0)
    bf16* XN = (bf16*)(ws + WS_XN);

    if (IN(0)) REPS(0) {
        LAS float* scr = (LAS float*)(lds + wave * 16384);
        const int gw = vcu * NWAVES + wave, NGW = G * NWAVES;
        const int ng1 = (G >= 64) ? NG1 : 0, nd8 = (G >= 64) ? ND8 : 0, nu3 = (G >= 64) ? NU3 : 0, wo0 = (G >= 64) ? 0 : I_O;
        {
            int base = 0;
#define P0_STREAM(W_, K_, N_, WT_, MODE_, FIRST_, CNT_) do { const int b_ = ((gw - base) % NGW + NGW) % NGW; \
                conv_stream(W_, K_, N_, WT_, MODE_, scr, (FIRST_) + b_, (FIRST_) + (CNT_), NGW, lane, ((MODE_) != 0) ? A.in[17] : nullptr); base += (CNT_); } while (0)
            P0_STREAM(A.in[2], DM, DIN, (bf16*)(ws + WS_WIN), 0, 0, I_IN);
            P0_STREAM(A.in[5], 768, 3072, (bf16*)(ws + WS_WUQ), 0, 0, I_UQ);
            P0_STREAM(A.in[6], 512, 4096, (bf16*)(ws + WS_WUKV), 0, 0, I_UKV);
            P0_STREAM(A.in[16], DM, DM, (bf16*)(ws + WS_WO), 0, 0, wo0);
            P0_STREAM(A.in[18], DM, DFF, (bf16*)(ws + WS_WGU), 1, ng1, I_G - ng1);
            P0_STREAM(A.in[19], DM, DFF, (bf16*)(ws + WS_WGU), 2, nu3, I_G - nu3);
            P0_STREAM(A.in[20], DFF, DM, (bf16*)(ws + WS_WDN), 0, nd8, I_D - nd8);
#undef P0_STREAM
        }
        { u32x4* pz = (u32x4*)(ws + WS_WIN + (size_t)DIN * DM * 2); const int n16 = (ZLD - DIN) * DM * 2 / 16; const u32x4 z4 = {0u, 0u, 0u, 0u};
            for (int i = vcu * 512 + tid; i < n16; i += G * 512) pz[i] = z4; }
        for (int mrow = gw; mrow < SEQ; mrow += NGW) rms_row_4096(A.in[0] + (size_t)mrow * DM, A.in[1], XN + (size_t)mrow * DM, lane);
        { float* rowss = (float*)(ws + WS_ROWSS); for (int i = vcu * 512 + tid; i < SEQ; i += G * 512) rowss[i] = 0.f; }
    }
    SEAM(0);
    if (IN(1)) REPS(1) {
        const int spare = (G >= 64) ? SPARE1 : 0, Gg = G - spare;
        if (bx < Gg) {
            pg8::Gemm g{XN, (const bf16*)(ws + WS_WIN), SEQ, ZLD, DM}; pg8::StaticOrder S; S.init(SEQ, ZLD, Gg, bx);
            pg8::EpiBf16S E{(bf16*)(ws + WS_Z), ZLD};
            pg8::gemm_phase<pg8::EpiBf16S, pg8::StaticOrder, true, true>(lds, g, S, E, tid);
        } else {
            LAS float* scr = (LAS float*)(lds + wave * 16384);
            const int sw = (bx - Gg) * NWAVES + wave, ns = spare * NWAVES;
            conv_stream(A.in[16], DM, DM, (bf16*)(ws + WS_WO), 0, scr, sw, I_O, ns, lane);
            conv_stream(A.in[18], DM, DFF, (bf16*)(ws + WS_WGU), 1, scr, sw, NG1, ns, lane, A.in[17]);
        }
    }
    SEAM(1);
    if (IN(2)) REPS(2) p2_phase(A, lds, vcu, G, tid, wave, lane);
    SEAM(2);
    if (IN(3)) REPS(3) {
        { pg8::Gemm g{(const bf16*)(ws + WS_CQN), (const bf16*)(ws + WS_WUQ), SEQ, 3072, 768}; pg8::StaticOrder S; S.init(SEQ, 3072, G, G - 1 - bx);
          pg8::EpiBf16S E{(bf16*)(ws + WS_QRAW), 3072};
          pg8::gemm_phase<pg8::EpiBf16S, pg8::StaticOrder, true, true>(lds, g, S, E, tid); }
        { pg8::Gemm g{(const bf16*)(ws + WS_CKVN), (const bf16*)(ws + WS_WUKV), SEQ, 4096, 512}; pg8::StaticOrder S; S.init(SEQ, 4096, G, bx);
          pg8::EpiBf16S E{(bf16*)(ws + WS_KVRAW), 4096};
          pg8::gemm_phase<pg8::EpiBf16S, pg8::StaticOrder, true, true>(lds, g, S, E, tid); }
        if (G >= 64 && bx < G / 2)
            conv_stream(A.in[19], DM, DFF, (bf16*)(ws + WS_WGU), 2, (LAS float*)(lds + wave * 16384), bx * NWAVES + wave, NU3, (G / 2) * NWAVES, lane, A.in[17]);
    }
    SEAM(3);
    if (IN(4)) REPS(4) p4_phase(A, lds, vcu, G, tid, wave, lane);
    SEAM(4);
    if (IN(5)) {
        float lam;
        { const float* q1 = A.in[11]; const float* k1 = A.in[12]; const float* q2 = A.in[13]; const float* k2 = A.in[14];
          const float s1 = wave_sum(q1[lane] * k1[lane] + q1[lane + 64] * k1[lane + 64]), s2 = wave_sum(q2[lane] * k2[lane] + q2[lane + 64] * k2[lane + 64]);
          lam = __uint_as_float(__builtin_amdgcn_readfirstlane(__float_as_uint(expf(s1) - expf(s2) + LAMBDA_INIT))); }
        const bf16* QA = (const bf16*)(ws + WS_QA); const bf16* KA = (const bf16*)(ws + WS_KA); const bf16* VAT = (const bf16*)(ws + WS_VAT);
        const bf16* QD = (const bf16*)(ws + WS_QD); const bf16* KD = (const bf16*)(ws + WS_KD); const bf16* VDT = (const bf16*)(ws + WS_VDT);
        bf16* OC = (bf16*)(ws + WS_OC);
        REPS(5) for (int p = vcu; p < 256; p += G) {
            { const int h = p >> 5, s = p & 31; att::diff_unit(h, 63 - s, lam, QD, KD, VDT, A.in[15], OC, lds, wave, lane); att::diff_unit(h, s, lam, QD, KD, VDT, A.in[15], OC, lds, wave, lane); }
            { const int h = p >> 4, s = p & 15; att::mla_unit(h, 31 - s, QA, KA, VAT, OC, lds, wave, lane); att::mla_unit(h, s, QA, KA, VAT, OC, lds, wave, lane); }
        }
    }
    SEAM(5);
    if (IN(6)) REPS(6) {
        pg8::Gemm g{(const bf16*)(ws + WS_OC), (const bf16*)(ws + WS_WO), SEQ, DM, DM}; pg8::StaticOrder S; S.init(SEQ, DM, G, bx);
        pg8::EpiHb E{A.in[0], XN, DM};
        pg8::gemm_phase<pg8::EpiHb, pg8::StaticOrder, true, true>(lds, g, S, E, wave * 64 + fresh_lane());
    }
    SEAM(6);
    if (IN(7)) {
        const int gw = vcu * NWAVES + wave, NGW = G * NWAVES, lf = fresh_lane(); float* rowss = (float*)(ws + WS_ROWSS);
        for (int mrow = gw; mrow < SEQ; mrow += NGW) { const u32x4* p = (const u32x4*)(XN + (size_t)mrow * DM) + lf; float sq = 0.f;
#pragma unroll
            for (int j = 0; j < 8; ++j) { float v[8]; unpack8(p[64 * j], v);
#pragma unroll
                for (int e = 0; e < 8; ++e) sq += v[e] * v[e]; }
            sq = wave_sum(sq); if (lf == 0) rowss[mrow] = sq; }
    }
    SEAM(7);
    if (IN(8)) REPS(8) {
        const int spare = (G >= 64) ? SPARE8 : 0, Gg = G - spare;
        if (bx < Gg) {
            pg8::Gemm g{XN, (const bf16*)(ws + WS_WGU), SEQ, 2 * DFF, DM}; pg8::StaticOrder S; S.init(SEQ, 2 * DFF, Gg, bx);
            pg8::EpiSwiGLU E{(bf16*)(ws + WS_ACT), DFF, (const float*)(ws + WS_ROWSS), 1.0f / DM, EPS};
            pg8::gemm_phase<pg8::EpiSwiGLU, pg8::StaticOrder, true, true>(lds, g, S, E, wave * 64 + fresh_lane());
        } else {
            LAS float* scr = (LAS float*)(lds + wave * 16384);
            conv_stream(A.in[20], DFF, DM, (bf16*)(ws + WS_WDN), 0, scr, (bx - Gg) * NWAVES + wave, ND8, spare * NWAVES, fresh_lane());
        }
    }
    SEAM(8);
    if (IN(9)) REPS(9) {
        pg8::Gemm g{(const bf16*)(ws + WS_ACT), (const bf16*)(ws + WS_WDN), SEQ, DM, DFF}; pg8::StaticOrder S; S.init(SEQ, DM, G, bx);
        pg8::EpiOutHb E{XN, A.out, DM};
        pg8::gemm_phase<pg8::EpiOutHb, pg8::StaticOrder, true, true>(lds, g, S, E, wave * 64 + fresh_lane());
    }
#undef IN
#undef SEAM
}

#ifndef MK_PER_PHASE
#define MK_PER_PHASE 0
#endif
constexpr int N_PHASES = 10;
extern "C" void kernel_launch(void* const* d_in, const int* in_sizes, int n_in, void* d_out, int out_size, void* d_ws, size_t ws_size, hipStream_t stream) {
    static int grid = 0;
    if (grid == 0) {
        if (n_in != 21 || in_sizes[0] != SEQ * DM || out_size != SEQ * DM || ws_size < WS_END) { fprintf(stderr, "kernel_launch: unexpected shapes / workspace (n_in %d, ws %zu, need %zu)\n", n_in, ws_size, (size_t)WS_END); grid = -1; return; }
        int dev = 0, cus = 0, per_cu = 0;
        if (hipGetDevice(&dev) != hipSuccess || hipDeviceGetAttribute(&cus, hipDeviceAttributeMultiprocessorCount, dev) != hipSuccess) { grid = -1; return; }
        if (hipFuncSetAttribute((const void*)fwd_kernel, hipFuncAttributeMaxDynamicSharedMemorySize, LDS_BYTES) != hipSuccess) { fprintf(stderr, "kernel_launch: hipFuncSetAttribute failed\n"); grid = -1; return; }
        if (hipOccupancyMaxActiveBlocksPerMultiprocessor(&per_cu, (const void*)fwd_kernel, NWAVES * 64, LDS_BYTES) != hipSuccess || per_cu < 1) { fprintf(stderr, "kernel_launch: occupancy query gave %d\n", per_cu); per_cu = 1; }
        (void)hipGetLastError();
        grid = cus * per_cu;
    }
    if (grid < 0) return;
    if (hipMemsetAsync((char*)d_ws + WS_BAR, 0, XCD_BAR_WORDS * 4, stream) != hipSuccess) { fprintf(stderr, "kernel_launch: hipMemsetAsync failed\n"); return; }
    Args a{};
    for (int i = 0; i < 21; ++i) a.in[i] = (const float*)d_in[i];
    a.out = (float*)d_out; a.ws = (unsigned char*)d_ws;
    for (int j = 0; j < 64; ++j) a.invf[j] = (float)std::pow(10000.0, -(double)j / 64.0);
#if MK_PER_PHASE
#ifndef HOST_REP_MASK
#define HOST_REP_MASK 0
#endif
    for (int ph = 0; ph < N_PHASES; ++ph) for (int rep = 0; rep < (((HOST_REP_MASK >> ph) & 1) ? 2 : 1); ++rep) { a.ph_lo = ph; a.ph_hi = ph + 1; hipLaunchKernelGGL(fwd_kernel, dim3(grid), dim3(NWAVES * 64), LDS_BYTES, stream, a); }
#else
    a.ph_lo = 0; a.ph_hi = N_PHASES;
    void* args[] = {&a};
    hipError_t e = hipLaunchCooperativeKernel((const void*)fwd_kernel, dim3(grid), dim3(NWAVES * 64), args, LDS_BYTES, stream);
    if (e != hipSuccess) fprintf(stderr, "kernel_launch: cooperative launch failed: %s (grid %d)\n", hipGetErrorString(e), grid);
#endif
}
```

```cpp
#include <hip/hip_runtime.h>
#include <hip/hip_cooperative_groups.h>
#include <cstdio>
#include <cstdint>
#include <cmath>
namespace cg = cooperative_groups;
namespace pg8 {
#define PG8_LAS __attribute__((address_space(3)))
typedef unsigned short bf16_t;
typedef short bf16x8 __attribute__((ext_vector_type(8)));
typedef float f32x4 __attribute__((ext_vector_type(4)));
typedef unsigned u32x4 __attribute__((ext_vector_type(4)));
constexpr int BM = 256, BK = 64, HALF = 128, HTB = HALF * BK * 2  , STAGE_BYTES = 8 * HTB, NXCD = 8, WGM = 8;

__host__ __device__ __forceinline__ int lds_byte(int r, int c) { const int st = (r >> 4) * 2 + (c >> 5), rr = r & 15, cc = c & 31, ob = rr * 64 + cc * 2; return st * 1024 + (ob ^ (((ob >> 9) & 1) << 5)); }
__host__ __device__ __forceinline__ void stage_rc(int b, int& R, int& C) { const int st = b / 1024, sb = b % 1024, swz = sb ^ (((sb >> 9) & 1) << 5); R = (st >> 1) * 16 + swz / 64; C = (st & 1) * 32 + (swz % 64) / 2; }
__host__ __device__ __forceinline__ int perm32(int rho) { const int n = rho >> 4, i = rho & 15; return 8 * (i >> 2) + 4 * n + (i & 3); }

struct Unit { int pm, pn; };
struct Gemm { const bf16_t* A; const bf16_t* Bt; int M, N, K; };

struct StaticOrder {
    int nM, nN, nwg, G, c;
    __host__ __device__ void init(int M, int N, int G_, int c_) { nM = M / BM; nN = N / BM; nwg = nM * nN; G = G_; c = c_; }
    __host__ __device__ bool next(int i, Unit& u) const {
        const long L = (long)i * G + c; if (L >= nwg) return false;
        int wgid = (int)L; { const int q = nwg / NXCD, r = nwg % NXCD, xcd = wgid % NXCD, off = wgid / NXCD; wgid = (xcd < r ? xcd * (q + 1) : r * (q + 1) + (xcd - r) * q) + off; }
        const int nig = WGM * nN, gid = wgid / nig, fm = gid * WGM, gsz = (nM - fm) < WGM ? (nM - fm) : WGM;
        u.pm = fm + ((wgid % nig) % gsz); u.pn = (wgid % nig) / gsz; return true;
    }
    __device__ __forceinline__ void a_ready(const Unit&) const {}
    __device__ __forceinline__ void done(const Unit&) const {}
};

__device__ __forceinline__ unsigned cvt_pk_bf16(float lo, float hi) { unsigned r; asm volatile("v_cvt_pk_bf16_f32 %0, %1, %2" : "=v"(r) : "v"(lo), "v"(hi)); return r; }
typedef float f32x2 __attribute__((ext_vector_type(2)));
template <class Epi, class Sched, bool ALIGN_EPI = false, bool SP2 = false>
__device__ __forceinline__ void gemm_phase(PG8_LAS unsigned char* lds, const Gemm g, const Sched& S, const Epi& E, const int tid_in) {
    const int tid = tid_in, wid = __builtin_amdgcn_readfirstlane(tid >> 6), lane = tid & 63, wr = wid >> 2, wc = wid & 3, fr = lane & 15, fq = lane >> 4;
    const int K = g.K, nt = K / BK;
    unsigned voffA[2], voffB[2];
#pragma unroll
    for (int i = 0; i < 2; ++i) { int R, C; stage_rc(tid * 16 + i * 8192, R, C); const int Rb = Epi::PERM ? ((R & ~31) + perm32(R & 31)) : R;
        voffA[i] = (unsigned)(R * K + C) * 2u; voffB[i] = (unsigned)(Rb * K + C) * 2u; }
    const size_t kstep = (size_t)(BK * 2);
    const size_t hstep = (size_t)HALF * K * 2;
    const size_t tstep = 2 * hstep;
    const unsigned ldsw = (unsigned)wid * 1024u;
    const int aoff = lds_byte(wr * 64 + fr, fq * 8), boff = lds_byte(wc * 32 + fr, fq * 8);
#define PG8_SA(b, h) (((b) * 2 + (h)) * HTB)
#define PG8_SB(b, h) ((4 + (b) * 2 + (h)) * HTB)
#define PG8_STAGE(bufoff, gbase, voff) do { _Pragma("unroll") for (int _i = 0; _i < 2; ++_i) \
        __builtin_amdgcn_global_load_lds((const unsigned*)((const char*)(gbase) + (voff)[_i]), (PG8_LAS unsigned*)(lds + (bufoff) + ldsw + _i * 8192), 16, 0, 0); } while (0)
#define PG8_LDA(dst, b, h) do { _Pragma("unroll") for (int m = 0; m < 4; ++m) _Pragma("unroll") for (int k = 0; k < 2; ++k) dst[m][k] = *(const PG8_LAS bf16x8*)(lds + PG8_SA(b, h) + aoff + m * 2048 + k * 1024); } while (0)
#define PG8_LDB(dst, b, h) do { _Pragma("unroll") for (int n = 0; n < 2; ++n) _Pragma("unroll") for (int k = 0; k < 2; ++k) dst[n][k] = *(const PG8_LAS bf16x8*)(lds + PG8_SB(b, h) + boff + n * 2048 + k * 1024); } while (0)
#define PG8_MMA(ai, bj, At, Bt) do { __builtin_amdgcn_s_setprio(1); _Pragma("unroll") for (int m = 0; m < 4; ++m) _Pragma("unroll") for (int n = 0; n < 2; ++n) _Pragma("unroll") for (int k = 0; k < 2; ++k) \
        acc[ai][bj][m][n] = __builtin_amdgcn_mfma_f32_16x16x32_bf16(Bt[n][k], At[m][k], acc[ai][bj][m][n], 0, 0, 0); __builtin_amdgcn_s_setprio(0); } while (0)
#define PG8_WAIT_V(n) asm volatile("s_waitcnt vmcnt(" #n ")" ::: "memory")
#define PG8_WAIT_L(n) asm volatile("s_waitcnt lgkmcnt(" #n ")" ::: "memory")
#define PG8_BAR __builtin_amdgcn_s_barrier()
#define PG8_SCHED __builtin_amdgcn_sched_barrier(0)
    Unit cur, nxt; int ui = 0;
    if (!S.next(0, cur)) return;
    f32x4 acc[2][2][4][2];
#pragma unroll
    for (int a = 0; a < 2; ++a)
#pragma unroll
        for (int b = 0; b < 2; ++b)
#pragma unroll
            for (int m = 0; m < 4; ++m)
#pragma unroll
                for (int n = 0; n < 2; ++n) acc[a][b][m][n] = (f32x4){0.f, 0.f, 0.f, 0.f};
    bf16x8 At[4][2], B0[2][2], B1[2][2];
    const char* cA = (const char*)g.A + (size_t)cur.pm * tstep; const char* cB = (const char*)g.Bt + (size_t)cur.pn * tstep;
    S.a_ready(cur);
    if constexpr (SP2) {
        PG8_STAGE(PG8_SB(0, 0), cB, voffB); PG8_STAGE(PG8_SB(0, 1), cB + hstep, voffB); PG8_STAGE(PG8_SA(0, 0), cA, voffA); PG8_STAGE(PG8_SA(0, 1), cA + hstep, voffA);
        if (wr == 1) PG8_BAR;
        PG8_WAIT_V(2); PG8_BAR;
        PG8_STAGE(PG8_SB(1, 0), cB + kstep, voffB); PG8_STAGE(PG8_SA(1, 0), cA + kstep, voffA); PG8_STAGE(PG8_SB(1, 1), cB + hstep + kstep, voffB);
        PG8_WAIT_V(6); PG8_BAR;
    } else {
        PG8_STAGE(PG8_SB(0, 0), cB, voffB); PG8_STAGE(PG8_SA(0, 0), cA, voffA); PG8_STAGE(PG8_SB(0, 1), cB + hstep, voffB); PG8_STAGE(PG8_SA(0, 1), cA + hstep, voffA);
        if (wr == 1) PG8_BAR;
        PG8_WAIT_V(4); PG8_BAR;
        PG8_STAGE(PG8_SB(1, 0), cB + kstep, voffB); PG8_STAGE(PG8_SA(1, 0), cA + kstep, voffA); PG8_STAGE(PG8_SB(1, 1), cB + hstep + kstep, voffB);
        PG8_WAIT_V(6); PG8_BAR;
    }
    for (;;) {
        const bool has_next = S.next(ui + 1, nxt);
        const char* nA = has_next ? (const char*)g.A + (size_t)nxt.pm * tstep : cA; const char* nB = has_next ? (const char*)g.Bt + (size_t)nxt.pn * tstep : cB;
        for (int t = 0; t < nt; t += 2) {
            const bool last = (t == nt - 2);
            const char* a1 = cA + (size_t)(t + 1) * kstep;
            const char* a2 = last ? nA : cA + (size_t)(t + 2) * kstep; const char* b2 = last ? nB : cB + (size_t)(t + 2) * kstep;
            const char* a3 = a2 + kstep; const char* b3 = b2 + kstep;
            if (last && has_next) S.a_ready(nxt);
            if constexpr (SP2) {
            PG8_LDB(B0, 0, 0); PG8_LDB(B1, 0, 1); PG8_SCHED; PG8_LDA(At, 0, 0); PG8_STAGE(PG8_SA(1, 1), a1 + hstep, voffA);
            PG8_WAIT_V(8); PG8_WAIT_L(0); PG8_BAR; PG8_MMA(0, 0, At, B0); PG8_MMA(0, 1, At, B1); PG8_BAR; PG8_SCHED;
            PG8_LDA(At, 0, 1); PG8_STAGE(PG8_SB(0, 0), b2, voffB); PG8_STAGE(PG8_SB(0, 1), b2 + hstep, voffB); PG8_STAGE(PG8_SA(0, 0), a2, voffA);
            PG8_WAIT_V(8); PG8_WAIT_L(0); PG8_BAR; PG8_MMA(1, 0, At, B0); PG8_MMA(1, 1, At, B1); PG8_BAR; PG8_SCHED;
            PG8_LDB(B0, 1, 0); PG8_LDB(B1, 1, 1); PG8_SCHED; PG8_LDA(At, 1, 0); PG8_STAGE(PG8_SA(0, 1), a2 + hstep, voffA);
            PG8_WAIT_V(8); PG8_WAIT_L(0); PG8_BAR; PG8_MMA(0, 0, At, B0); PG8_MMA(0, 1, At, B1); PG8_BAR; PG8_SCHED;
            PG8_LDA(At, 1, 1); PG8_STAGE(PG8_SB(1, 0), b3, voffB); PG8_STAGE(PG8_SB(1, 1), b3 + hstep, voffB); PG8_STAGE(PG8_SA(1, 0), a3, voffA);
            PG8_WAIT_V(8); PG8_WAIT_L(0); PG8_BAR; PG8_MMA(1, 0, At, B0); PG8_MMA(1, 1, At, B1); PG8_BAR; PG8_SCHED;
            } else {
            PG8_LDB(B0, 0, 0); PG8_SCHED; PG8_LDA(At, 0, 0); PG8_STAGE(PG8_SA(1, 1), a1 + hstep, voffA);
            PG8_WAIT_L(8); PG8_BAR; PG8_WAIT_L(0); PG8_MMA(0, 0, At, B0); PG8_BAR; PG8_SCHED;
            PG8_LDB(B1, 0, 1); PG8_STAGE(PG8_SB(0, 0), b2, voffB);
            PG8_BAR; PG8_WAIT_L(0); PG8_MMA(0, 1, At, B1); PG8_BAR;
            PG8_LDA(At, 0, 1); PG8_STAGE(PG8_SA(0, 0), a2, voffA);
            PG8_BAR; PG8_WAIT_L(0); PG8_MMA(1, 0, At, B0); PG8_BAR; PG8_SCHED;
            PG8_STAGE(PG8_SB(0, 1), b2 + hstep, voffB);
            PG8_WAIT_V(6); PG8_BAR; PG8_MMA(1, 1, At, B1); PG8_BAR;
            PG8_LDB(B0, 1, 0); PG8_SCHED; PG8_LDA(At, 1, 0); PG8_STAGE(PG8_SA(0, 1), a2 + hstep, voffA);
            PG8_WAIT_L(8); PG8_BAR; PG8_WAIT_L(0); PG8_MMA(0, 0, At, B0); PG8_BAR; PG8_SCHED;
            PG8_LDB(B1, 1, 1); PG8_STAGE(PG8_SB(1, 0), b3, voffB);
            PG8_BAR; PG8_WAIT_L(0); PG8_MMA(0, 1, At, B1); PG8_BAR;
            PG8_LDA(At, 1, 1); PG8_STAGE(PG8_SA(1, 0), a3, voffA);
            PG8_BAR; PG8_WAIT_L(0); PG8_MMA(1, 0, At, B0); PG8_BAR; PG8_SCHED;
            PG8_STAGE(PG8_SB(1, 1), b3 + hstep, voffB);
            PG8_WAIT_V(6); PG8_BAR; PG8_MMA(1, 1, At, B1); PG8_BAR;
            }
        }
        if constexpr (ALIGN_EPI) { if (wr == 0) PG8_BAR; }
        if constexpr (!Epi::AFTER_DRAIN) { E(acc, cur, wr, wc, fr, fq); S.done(cur); }
        if (!has_next) break;
#pragma unroll
        for (int a = 0; a < 2; ++a)
#pragma unroll
            for (int b = 0; b < 2; ++b)
#pragma unroll
                for (int m = 0; m < 4; ++m)
#pragma unroll
                    for (int n = 0; n < 2; ++n) acc[a][b][m][n] = (f32x4){0.f, 0.f, 0.f, 0.f};
        cur = nxt; cA = nA; cB = nB; ++ui;
        if constexpr (ALIGN_EPI) { if (wr == 1) PG8_BAR; }
    }
    PG8_WAIT_V(0);
    if constexpr (!ALIGN_EPI) { if (wr == 0) PG8_BAR; }
    PG8_BAR;
    if constexpr (Epi::AFTER_DRAIN) { E.fused(acc, cur, wr, wc, fr, fq, lds, wid, lane); S.done(cur); }
#undef PG8_SA
#undef PG8_SB
#undef PG8_STAGE
#undef PG8_LDA
#undef PG8_LDB
#undef PG8_MMA
#undef PG8_WAIT_V
#undef PG8_WAIT_L
#undef PG8_BAR
#undef PG8_SCHED
}
}

namespace pg8 {
typedef float f32x2e __attribute__((ext_vector_type(2))); typedef __bf16 bf16x2e __attribute__((ext_vector_type(2)));
__device__ __forceinline__ unsigned pk_bf16(float lo, float hi) { f32x2e v = {lo, hi}; bf16x2e b = __builtin_convertvector(v, bf16x2e); return __builtin_bit_cast(unsigned, b); }
struct EpiBf16S {
    static constexpr bool PERM = true, AFTER_DRAIN = false;
    bf16_t* O; int ldc;
    __device__ __forceinline__ void operator()(const f32x4 (&acc)[2][2][4][2], const Unit& u, int wr, int wc, int fr, int fq) const {
        const int row0 = u.pm * BM + wr * 64 + fr, col0 = u.pn * BM + wc * 32 + 8 * fq;
#pragma unroll
        for (int ai = 0; ai < 2; ++ai)
#pragma unroll
            for (int m = 0; m < 4; ++m) { bf16_t* rowp = O + (size_t)(row0 + ai * HALF + m * 16) * ldc + col0;
#pragma unroll
                for (int bj = 0; bj < 2; ++bj) { const f32x4 v0 = acc[ai][bj][m][0], v1 = acc[ai][bj][m][1];
                    u32x4 w; w.x = pk_bf16(v0[0], v0[1]); w.y = pk_bf16(v0[2], v0[3]); w.z = pk_bf16(v1[0], v1[1]); w.w = pk_bf16(v1[2], v1[3]);
                    *(u32x4*)(rowp + bj * HALF) = w; } }
    }
};
struct EpiResF32 {
    static constexpr bool PERM = false, AFTER_DRAIN = false;
    const float* base; float* out; int ldc;
    __device__ __forceinline__ void operator()(const f32x4 (&acc)[2][2][4][2], const Unit& u, int wr, int wc, int fr, int fq) const {
        const int col0 = u.pn * BM + wc * 32 + 4 * fq;
#pragma unroll
        for (int ai = 0; ai < 2; ++ai)
#pragma unroll
            for (int m = 0; m < 4; ++m) { const int r = u.pm * BM + ai * HALF + wr * 64 + m * 16 + fr; const size_t off = (size_t)r * ldc + col0;
#pragma unroll
                for (int bj = 0; bj < 2; ++bj)
#pragma unroll
                    for (int n = 0; n < 2; ++n) { const f32x4 b = *(const f32x4*)(base + off + bj * HALF + n * 16); *(f32x4*)(out + off + bj * HALF + n * 16) = b + acc[ai][bj][m][n]; } }
    }
};
struct EpiSwiGLU {
    static constexpr bool PERM = true, AFTER_DRAIN = false;
    bf16_t* O; int ldc;
    __device__ __forceinline__ static float act(float g, float u) { return g * u * __builtin_amdgcn_rcpf(1.0f + __builtin_amdgcn_exp2f(-1.4426950408889634f * g)); }
    __device__ __forceinline__ void operator()(const f32x4 (&acc)[2][2][4][2], const Unit& u, int wr, int wc, int fr, int fq) const {
        const int row0 = u.pm * BM + wr * 64 + fr, col0 = u.pn * HALF + wc * 32 + 8 * fq;
#pragma unroll
        for (int ai = 0; ai < 2; ++ai)
#pragma unroll
            for (int m = 0; m < 4; ++m) { bf16_t* rowp = O + (size_t)(row0 + ai * HALF + m * 16) * ldc + col0;
                const f32x4 g0 = acc[ai][0][m][0], g1 = acc[ai][0][m][1], u0 = acc[ai][1][m][0], u1 = acc[ai][1][m][1];
                u32x4 w; w.x = pk_bf16(act(g0[0], u0[0]), act(g0[1], u0[1])); w.y = pk_bf16(act(g0[2], u0[2]), act(g0[3], u0[3]));
                w.z = pk_bf16(act(g1[0], u1[0]), act(g1[1], u1[1])); w.w = pk_bf16(act(g1[2], u1[2]), act(g1[3], u1[3]));
                *(u32x4*)(rowp) = w; }
    }
};
}

#define GAS __attribute__((address_space(1)))
#define LAS __attribute__((address_space(3)))
typedef unsigned short bf16;
typedef unsigned u32x4 __attribute__((ext_vector_type(4)));
typedef unsigned u32x2 __attribute__((ext_vector_type(2)));
typedef float f32x4 __attribute__((ext_vector_type(4)));
typedef short bf16x8 __attribute__((ext_vector_type(8)));
typedef float f32x16 __attribute__((ext_vector_type(16)));
constexpr int SEQ = 8192, DM = 4096, DIN = 7488, ZLD = 7680, DFF = 11008;
constexpr int C_CKV = 768, C_KPE = 1280, C_DQ = 1344, C_DK = 3392, C_DV = 5440;
constexpr float EPS = 1e-6f, LOG2E = 1.4426950408889634f;
constexpr float QSC_MLA = 0.07216878364870323f * LOG2E;
constexpr float QSC_DIFF = 0.08838834764831845f * LOG2E;
constexpr float LAMBDA_INIT = 0.2f;
constexpr int NWAVES = 8;
constexpr int LDS_BYTES = 147456;

constexpr size_t WS_BAR = 0;
constexpr size_t WS_WIN = 16384;
constexpr size_t WS_WUQ = WS_WIN + (size_t)ZLD * DM * 2;
constexpr size_t WS_WUKV = WS_WUQ + (size_t)3072 * 768 * 2;
constexpr size_t WS_WO = WS_WUKV + (size_t)4096 * 512 * 2;
constexpr size_t WS_WGU = WS_WO + (size_t)DM * DM * 2;
constexpr size_t WS_WDN = WS_WGU + (size_t)2 * DFF * DM * 2;
constexpr size_t WS_XN = WS_WDN + (size_t)DM * DFF * 2;
constexpr size_t WS_R1 = WS_XN + (size_t)SEQ * DM * 2;
constexpr size_t WS_Z = WS_R1;
constexpr size_t WS_CQN = WS_Z + (size_t)SEQ * ZLD * 2;
constexpr size_t WS_CKVN = WS_CQN + (size_t)SEQ * 768 * 2;
constexpr size_t WS_QRAW = WS_CKVN + (size_t)SEQ * 512 * 2;
constexpr size_t WS_KVRAW = WS_QRAW + (size_t)SEQ * 3072 * 2;
constexpr size_t WS_R1END = WS_KVRAW + (size_t)SEQ * 4096 * 2;
constexpr size_t WS_QA = WS_R1;
constexpr size_t WS_KA = WS_QA + (size_t)SEQ * 3072 * 2;
constexpr size_t WS_VAT = WS_KA + (size_t)SEQ * 3072 * 2;
static_assert(WS_VAT + (size_t)SEQ * 2048 * 2 <= WS_QRAW, "QA|KA|VAT overlay z|cqn|ckvn only");
constexpr size_t WS_OC = WS_QRAW;
constexpr size_t WS_ACT = WS_R1;
static_assert(WS_ACT + (size_t)SEQ * DFF * 2 <= WS_R1END, "act inside R1");
constexpr size_t WS_QD = WS_R1END;
constexpr size_t WS_KD = WS_QD + (size_t)SEQ * 2048 * 2;
constexpr size_t WS_VDT = WS_KD + (size_t)SEQ * 2048 * 2;
constexpr size_t WS_KPE = WS_VDT + (size_t)SEQ * 2048 * 2;
constexpr size_t WS_END = WS_KPE + (size_t)SEQ * 64 * 2;

struct Args { const float* in[21]; float* out; unsigned char* ws; float invf[64]; int ph_lo, ph_hi; };
static_assert(sizeof(Args) == 21 * 8 + 8 + 8 + 256 + 8, "Args has no padding");

__device__ __forceinline__ float wave_sum(float v) {
#pragma unroll
    for (int o = 1; o < 64; o <<= 1) v += __shfl_xor(v, o);
    return v;
}
__device__ __forceinline__ float bflo(unsigned w) { return __uint_as_float(w << 16); }
__device__ __forceinline__ float bfhi(unsigned w) { return __uint_as_float(w & 0xffff0000u); }
__device__ __forceinline__ void unpack8(const u32x4 a, float (&v)[8]) {
    v[0] = bflo(a.x); v[1] = bfhi(a.x); v[2] = bflo(a.y); v[3] = bfhi(a.y); v[4] = bflo(a.z); v[5] = bfhi(a.z); v[6] = bflo(a.w); v[7] = bfhi(a.w);
}
__device__ __forceinline__ u32x4 pack8(const float (&v)[8]) {
    u32x4 w; w.x = pg8::pk_bf16(v[0], v[1]); w.y = pg8::pk_bf16(v[2], v[3]); w.z = pg8::pk_bf16(v[4], v[5]); w.w = pg8::pk_bf16(v[6], v[7]); return w;
}
__device__ __forceinline__ u32x4 ld16(const bf16* p) { return *(const u32x4*)p; }
__device__ __forceinline__ void st16(bf16* p, u32x4 v) { *(u32x4*)p = v; }
__device__ __forceinline__ void ldg8(const float* g, float (&v)[8]) { const f32x4 a = *(const f32x4*)g, b = *(const f32x4*)(g + 4); v[0] = a.x; v[1] = a.y; v[2] = a.z; v[3] = a.w; v[4] = b.x; v[5] = b.y; v[6] = b.z; v[7] = b.w; }
__device__ __forceinline__ void rope_cs(int pos, float invf, float& c, float& s) {
    const float ang = (float)pos * invf; const double rev = (double)ang * 0.15915494309189535; const float fr = (float)(rev - __builtin_rint(rev));
    c = __builtin_amdgcn_cosf(fr); s = __builtin_amdgcn_sinf(fr);
}

__device__ __forceinline__ void p0_transpose_item(const float* W, int K, int N, bf16* WT, int mode, LAS float* scr, int item, int lane) {
    const int nblk = N / 32, kb = item / nblk, nb = item % nblk, k0 = 64 * kb, n0 = 32 * nb;
    {
        f32x4 t[8]; const int kq = lane >> 3, n4 = (lane & 7) * 4;
#pragma unroll
        for (int i = 0; i < 8; ++i) t[i] = *(const f32x4*)(W + (size_t)(k0 + kq + 8 * i) * N + n0 + n4);
#pragma unroll
        for (int i = 0; i < 8; ++i) { LAS float* d = scr + (kq + 8 * i) * 33 + n4; d[0] = t[i].x; d[1] = t[i].y; d[2] = t[i].z; d[3] = t[i].w; }
    }
    asm volatile("s_waitcnt lgkmcnt(0)" ::: "memory");
    const int c = lane & 7;
    const int rbase = (mode == 0) ? n0 : (((n0 >> 7) << 8) + (n0 & 127) + (mode == 2 ? 128 : 0));
#pragma unroll
    for (int j = 0; j < 4; ++j) { const int n = (lane >> 3) + 8 * j; const LAS float* s = scr + (8 * c) * 33 + n;
        u32x4 o; o.x = pg8::pk_bf16(s[0 * 33], s[1 * 33]); o.y = pg8::pk_bf16(s[2 * 33], s[3 * 33]); o.z = pg8::pk_bf16(s[4 * 33], s[5 * 33]); o.w = pg8::pk_bf16(s[6 * 33], s[7 * 33]);
        *(u32x4*)(WT + (size_t)(rbase + n) * K + k0 + 8 * c) = o; }
    asm volatile("s_waitcnt lgkmcnt(0)" ::: "memory");
}
struct ItemRegs { f32x4 t[8]; };
__device__ __forceinline__ void item_load(ItemRegs& R, const float* W, int N, int item, int lane) {
    const int nblk = N / 32, kb = item / nblk, nb = item % nblk, k0 = 64 * kb, n0 = 32 * nb, kq = lane >> 3, n4 = (lane & 7) * 4;
#pragma unroll
    for (int i = 0; i < 8; ++i) R.t[i] = *(const f32x4*)(W + (size_t)(k0 + kq + 8 * i) * N + n0 + n4);
}
__device__ __forceinline__ void item_store(const ItemRegs& R, int K, int N, bf16* WT, int mode, LAS float* scr, int item, int lane) {
    const int nblk = N / 32, kb = item / nblk, nb = item % nblk, k0 = 64 * kb, n0 = 32 * nb, kq = lane >> 3, n4 = (lane & 7) * 4;
#pragma unroll
    for (int i = 0; i < 8; ++i) { LAS float* d = scr + (kq + 8 * i) * 33 + n4; d[0] = R.t[i].x; d[1] = R.t[i].y; d[2] = R.t[i].z; d[3] = R.t[i].w; }
    asm volatile("s_waitcnt lgkmcnt(0)" ::: "memory");
    const int c = lane & 7;
    const int rbase = (mode == 0) ? n0 : (((n0 >> 7) << 8) + (n0 & 127) + (mode == 2 ? 128 : 0));
#pragma unroll
    for (int j = 0; j < 4; ++j) { const int n = (lane >> 3) + 8 * j; const LAS float* s = scr + (8 * c) * 33 + n;
        u32x4 o; o.x = pg8::pk_bf16(s[0 * 33], s[1 * 33]); o.y = pg8::pk_bf16(s[2 * 33], s[3 * 33]); o.z = pg8::pk_bf16(s[4 * 33], s[5 * 33]); o.w = pg8::pk_bf16(s[6 * 33], s[7 * 33]);
        *(u32x4*)(WT + (size_t)(rbase + n) * K + k0 + 8 * c) = o; }
    asm volatile("s_waitcnt lgkmcnt(0)" ::: "memory");
}
__device__ __forceinline__ void conv_stream(const float* W, int K, int N, bf16* WT, int mode, LAS float* scr, int begin, int end, int stride, int lane) {
    if (begin >= end) return;
    ItemRegs r0, r1, r2; item_load(r0, W, N, begin, lane); if (begin + stride < end) item_load(r1, W, N, begin + stride, lane);
    for (int it = begin; it < end; it += stride) { const int it2 = it + 2 * stride; if (it2 < end) item_load(r2, W, N, it2, lane); item_store(r0, K, N, WT, mode, scr, it, lane); r0 = r1; r1 = r2; }
}
__device__ __forceinline__ void rms_row_4096(const float* xrow, const float* g, bf16* orow, int lane) {
    const f32x4* xr = (const f32x4*)xrow + lane; f32x4 v[16]; float s = 0.f;
#pragma unroll
    for (int j = 0; j < 16; ++j) { v[j] = xr[64 * j]; s += (v[j].x * v[j].x + v[j].y * v[j].y) + (v[j].z * v[j].z + v[j].w * v[j].w); }
    const float rstd = 1.0f / sqrtf(wave_sum(s) * (1.f / 4096.f) + EPS);
    const f32x4* gr = (const f32x4*)g + lane; u32x2* o8 = (u32x2*)orow + lane;
#pragma unroll
    for (int j = 0; j < 16; ++j) { const f32x4 gg = gr[64 * j]; u32x2 w; w.x = pg8::pk_bf16(v[j].x * rstd * gg.x, v[j].y * rstd * gg.y); w.y = pg8::pk_bf16(v[j].z * rstd * gg.z, v[j].w * rstd * gg.w); o8[64 * j] = w; }
}
#define RLX_AGENT __ATOMIC_RELAXED, __HIP_MEMORY_SCOPE_AGENT
#define XB_TMO      128
#define XB_XCNT(j)  (256  + 64 * (j))
#define XB_XSUB(j)  (1280 + 64 * (j))
#define XB_XGEN(j)  (2304 + 64 * (j))
#define XB_TOP      3328
#define XB_TOPGEN   3392
#define XCD_BAR_WORDS 3456
#define XB_SPIN_CAP (1u << 18)

__device__ __forceinline__ unsigned xb_ld(unsigned* p)              { return __hip_atomic_load(p, __ATOMIC_RELAXED, __HIP_MEMORY_SCOPE_AGENT); }
__device__ __forceinline__ unsigned xb_add(unsigned* p, unsigned v) { return __hip_atomic_fetch_add(p, v, __ATOMIC_RELAXED, __HIP_MEMORY_SCOPE_AGENT); }
__device__ __forceinline__ unsigned xb_xcc_id() { return (unsigned)__builtin_amdgcn_s_getreg((3 << 11) | 20) & 0xFu; }
#define XB_SPIN(cond, bar) do { unsigned _sp = 0; while (cond) { __builtin_amdgcn_s_sleep(1); \
    if ((++_sp & 255u) == 0u) { if (xb_ld(&(bar)[XB_TMO])) break; if (_sp > XB_SPIN_CAP) { atomicAdd(&(bar)[XB_TMO], 1u); break; } } } } while (0)

struct XcdBarrier {
    unsigned* bar; unsigned x;
    volatile LAS unsigned* st;
};

__device__ __forceinline__ XcdBarrier xcd_barrier_post(unsigned* bar, volatile LAS unsigned* st, bool t0) {
    XcdBarrier b; b.bar = bar; b.x = xb_xcc_id(); b.st = st;
    if (t0) (void)xb_add(&bar[XB_XCNT(b.x)], 1u);
    return b;
}
__device__ __forceinline__ void xcd_barrier_complete(unsigned* bar, unsigned x, unsigned& nloc, unsigned& nx) {
    const unsigned G = gridDim.x * gridDim.y * gridDim.z;
    unsigned sum, cnt, mine, sp = 0u;
    for (;;) {
        sum = 0u; cnt = 0u; mine = 0u;
#pragma unroll
        for (unsigned j = 0; j < 16; ++j) { const unsigned c = xb_ld(&bar[XB_XCNT(j)]); sum += c; cnt += (c > 0u) ? 1u : 0u; mine = (j == x) ? c : mine; }
        if (sum == G) break;
        __builtin_amdgcn_s_sleep(1);
        if ((++sp & 255u) == 0u) { if (xb_ld(&bar[XB_TMO])) break; if (sp > XB_SPIN_CAP) { atomicAdd(&bar[XB_TMO], 1u); break; } }
    }
    nloc = mine > 0u ? mine : 1u; nx = cnt > 0u ? cnt : 1u;
}

__device__ __forceinline__ void xcd_barrier(const XcdBarrier& b, bool t0) {
    asm volatile("s_waitcnt vmcnt(0)" ::: "memory");
    __syncthreads();
    if (t0) {
        unsigned* bar = b.bar;
        __builtin_amdgcn_s_waitcnt(0);
        unsigned nloc = b.st[0], nx = b.st[1];
        if (nloc == 0u) { xcd_barrier_complete(bar, b.x, nloc, nx); b.st[0] = nloc; b.st[1] = nx; }
        const unsigned old = xb_add(&bar[XB_XSUB(b.x)], 1u);
        const unsigned gen = old / nloc;
        if (old + 1u == (gen + 1u) * nloc) {
            __builtin_amdgcn_fence(__ATOMIC_RELEASE, "agent");
            asm volatile("s_waitcnt vmcnt(0)" ::: "memory");
            const unsigned og = xb_add(&bar[XB_TOP], 1u);
            const unsigned tg = og / nx;
            if (og + 1u == (tg + 1u) * nx) xb_add(&bar[XB_TOPGEN], 1u);
            else XB_SPIN(xb_ld(&bar[XB_TOPGEN]) == tg, bar);
            __builtin_amdgcn_fence(__ATOMIC_ACQUIRE, "agent");
            xb_add(&bar[XB_XGEN(b.x)], 1u);
            asm volatile("s_waitcnt vmcnt(0)" ::: "memory");
        } else {
            XB_SPIN(xb_ld(&bar[XB_XGEN(b.x)]) == gen, bar);
            __builtin_amdgcn_fence(__ATOMIC_ACQUIRE, "agent");
            asm volatile("s_waitcnt vmcnt(0)" ::: "memory");
        }
    }
    __syncthreads();
}

constexpr int TP_PITCH = 1040;
__device__ __forceinline__ void tp_store(LAS const unsigned char* tl, bf16* dst, int s0, int tid) {
#pragma unroll
    for (int k = 0; k < 4; ++k) { const int idx = tid + 512 * k, sg = idx & 3, col = idx >> 2; const LAS unsigned char* p = tl + (8 * sg) * TP_PITCH + 2 * col;
        unsigned short e[8];
#pragma unroll
        for (int i = 0; i < 8; ++i) e[i] = *(const LAS unsigned short*)(p + i * TP_PITCH);
        u32x4 w; w.x = e[0] | ((unsigned)e[1] << 16); w.y = e[2] | ((unsigned)e[3] << 16); w.z = e[4] | ((unsigned)e[5] << 16); w.w = e[6] | ((unsigned)e[7] << 16);
        st16(dst + (size_t)col * SEQ + s0 + 8 * sg, w); }
}

struct P2Row { u32x4 cq0, cq1, ckv, kpe, dq[4], dk[4]; };
__device__ __forceinline__ void p2_load(P2Row& R, const bf16* zr, int lane) {
    const u32x4 z4 = {0u, 0u, 0u, 0u}; const int sub = lane & 15;
    R.cq0 = ld16(zr + 8 * lane); R.cq1 = (lane < 32) ? ld16(zr + 512 + 8 * lane) : z4; R.ckv = ld16(zr + C_CKV + 8 * lane); R.kpe = (lane < 8) ? ld16(zr + C_KPE + 8 * lane) : z4;
#pragma unroll
    for (int rd = 0; rd < 4; ++rd) { const int head = rd * 4 + (lane >> 4); R.dq[rd] = ld16(zr + C_DQ + head * 128 + sub * 8); R.dk[rd] = ld16(zr + C_DK + head * 128 + sub * 8); }
}
__device__ __forceinline__ void p2_phase(const Args& A, LAS unsigned char* lds, int vcu, int G, int tid, int wave, int lane) {
    unsigned char* ws = A.ws;
    const bf16* Z = (const bf16*)(ws + WS_Z); bf16* CQN = (bf16*)(ws + WS_CQN); bf16* CKVN = (bf16*)(ws + WS_CKVN); bf16* KPE = (bf16*)(ws + WS_KPE);
    bf16* QD = (bf16*)(ws + WS_QD); bf16* KD = (bf16*)(ws + WS_KD); bf16* VDT = (bf16*)(ws + WS_VDT);
    const int sub = lane & 15;
    float gq0[8], gq1[8], gkv[8], gdq[8], gdk[8];
    ldg8(A.in[3] + 8 * lane, gq0); ldg8(A.in[3] + 512 + 8 * (lane & 31), gq1); ldg8(A.in[4] + 8 * lane, gkv); ldg8(A.in[9] + 8 * sub, gdq); ldg8(A.in[10] + 8 * sub, gdk);
    float ifr[8];
#pragma unroll
    for (int e = 0; e < 8; ++e) ifr[e] = A.invf[8 * (sub & 7) + e];
    for (int unit = vcu; unit < SEQ / 32; unit += G) {
        const int s0 = unit * 32;
        P2Row cur, nxt;
        p2_load(cur, Z + (size_t)(s0 + wave * 4) * ZLD, lane);
#pragma unroll
        for (int i = 0; i < 4; ++i) {
            const int row = s0 + wave * 4 + i;
            if (i < 3) p2_load(nxt, Z + (size_t)(row + 1) * ZLD, lane);
            {
                float va[8], vb[8]; unpack8(cur.cq0, va); unpack8(cur.cq1, vb); float ss = 0.f;
#pragma unroll
                for (int e = 0; e < 8; ++e) ss += va[e] * va[e] + vb[e] * vb[e];
                const float rstd = 1.0f / sqrtf(wave_sum(ss) * (1.f / 768.f) + EPS);
#pragma unroll
                for (int e = 0; e < 8; ++e) { va[e] = va[e] * rstd * gq0[e]; vb[e] = vb[e] * rstd * gq1[e]; }
                st16(CQN + (size_t)row * 768 + 8 * lane, pack8(va));
                if (lane < 32) st16(CQN + (size_t)row * 768 + 512 + 8 * lane, pack8(vb));
            }
            {
                float va[8]; unpack8(cur.ckv, va); float ss = 0.f;
#pragma unroll
                for (int e = 0; e < 8; ++e) ss += va[e] * va[e];
                const float rstd = 1.0f / sqrtf(wave_sum(ss) * (1.f / 512.f) + EPS);
#pragma unroll
                for (int e = 0; e < 8; ++e) va[e] = va[e] * rstd * gkv[e];
                st16(CKVN + (size_t)row * 512 + 8 * lane, pack8(va));
            }
            if (lane < 8) st16(KPE + (size_t)row * 64 + 8 * lane, cur.kpe);
            float cs[8], sn[8];
#pragma unroll
            for (int e = 0; e < 8; ++e) rope_cs(row, ifr[e], cs[e], sn[e]);
#pragma unroll
            for (int which = 0; which < 2; ++which) {
                bf16* dst = which ? KD : QD; const float osc = which ? 1.0f : QSC_DIFF;
#pragma unroll
                for (int rd = 0; rd < 4; ++rd) {
                    const int head = rd * 4 + (lane >> 4);
                    float v[8]; unpack8(which ? cur.dk[rd] : cur.dq[rd], v); float ss = 0.f;
#pragma unroll
                    for (int e = 0; e < 8; ++e) ss += v[e] * v[e];
                    ss += __shfl_xor(ss, 1); ss += __shfl_xor(ss, 2); ss += __shfl_xor(ss, 4); ss += __shfl_xor(ss, 8);
                    const float rstd = 1.0f / sqrtf(ss * (1.f / 128.f) + EPS);
                    float o[8];
#pragma unroll
                    for (int e = 0; e < 8; ++e) { const float y = v[e] * rstd * (which ? gdk[e] : gdq[e]); const float p = __shfl_xor(y, 8); o[e] = ((sub < 8) ? (y * cs[e] - p * sn[e]) : (y * cs[e] + p * sn[e])) * osc; }
                    st16(dst + (size_t)row * 2048 + head * 128 + sub * 8, pack8(o));
                }
            }
            cur = nxt;
        }
        for (int pass = 0; pass < 4; ++pass) {
            __syncthreads();
#pragma unroll
            for (int k = 0; k < 4; ++k) { const int idx = tid + 512 * k, r = idx >> 6, c = idx & 63;
                *(LAS u32x4*)(lds + r * TP_PITCH + 16 * c) = ld16(Z + (size_t)(s0 + r) * ZLD + C_DV + 512 * pass + 8 * c); }
            __syncthreads();
            tp_store(lds, VDT + (size_t)(512 * pass) * SEQ, s0, tid);
        }
        __syncthreads();
    }
}

struct P4Row { u32x4 q[8], k[8]; };
__device__ __forceinline__ void p4_load(P4Row& R, const bf16* QRAW, const bf16* KVRAW, const bf16* KPE, int row, int lane) {
    const u32x4 z4 = {0u, 0u, 0u, 0u}; const int sub = lane & 31, hsel = lane >> 5; const bool act = sub < 24;
    const u32x4 kpe = (sub >= 16 && act) ? ld16(KPE + (size_t)row * 64 + (sub - 16) * 8) : z4;
#pragma unroll
    for (int rd = 0; rd < 8; ++rd) { const int head = 2 * rd + hsel;
        R.q[rd] = act ? ld16(QRAW + (size_t)row * 3072 + head * 192 + sub * 8) : z4;
        R.k[rd] = (sub < 16) ? ld16(KVRAW + (size_t)row * 4096 + head * 256 + sub * 8) : kpe; }
}
__device__ __forceinline__ void p4_phase(const Args& A, LAS unsigned char* lds, int vcu, int G, int tid, int wave, int lane) {
    unsigned char* ws = A.ws;
    const bf16* QRAW = (const bf16*)(ws + WS_QRAW); const bf16* KVRAW = (const bf16*)(ws + WS_KVRAW); const bf16* KPE = (const bf16*)(ws + WS_KPE);
    bf16* QA = (bf16*)(ws + WS_QA); bf16* KA = (bf16*)(ws + WS_KA); bf16* VAT = (bf16*)(ws + WS_VAT);
    const int sub = lane & 31, hsel = lane >> 5; const bool act = sub < 24; const int subc = act ? sub : 0;
    const bool rlo = (sub >= 16 && sub < 20), rhi = (sub >= 20 && sub < 24);
    float gq[8], gk[8]; ldg8(A.in[7] + 8 * subc, gq); ldg8(A.in[8] + 8 * subc, gk);
    float ifr[8];
#pragma unroll
    for (int e = 0; e < 8; ++e) ifr[e] = A.invf[2 * (8 * (sub & 3) + e)];
    for (int unit = vcu; unit < SEQ / 32; unit += G) {
        const int s0 = unit * 32;
        for (int i = 0; i < 4; ++i) {
            const int row = s0 + wave * 4 + i;
            P4Row cur; { int lo_ = lane; asm volatile("" : "+v"(lo_)); p4_load(cur, QRAW, KVRAW, KPE, row, lo_); }
            float cs[8], sn[8];
#pragma unroll
            for (int e = 0; e < 8; ++e) rope_cs(row, ifr[e], cs[e], sn[e]);
#pragma unroll
            for (int which = 0; which < 2; ++which) {
                bf16* dst = which ? KA : QA; const float osc = which ? 1.0f : QSC_MLA;
#pragma unroll
                for (int rd = 0; rd < 8; ++rd) {
                    const int head = 2 * rd + hsel;
                    float v[8]; unpack8(which ? cur.k[rd] : cur.q[rd], v); float ss = 0.f;
#pragma unroll
                    for (int e = 0; e < 8; ++e) ss += v[e] * v[e];
                    ss += __shfl_xor(ss, 1); ss += __shfl_xor(ss, 2); ss += __shfl_xor(ss, 4); ss += __shfl_xor(ss, 8); ss += __shfl_xor(ss, 16);
                    const float rstd = 1.0f / sqrtf(ss * (1.f / 192.f) + EPS);
                    float o[8];
#pragma unroll
                    for (int e = 0; e < 8; ++e) { const float y = v[e] * rstd * (which ? gk[e] : gq[e]); const float p = __shfl_xor(y, 4);
                        float r = y; if (rlo) r = y * cs[e] - p * sn[e]; if (rhi) r = y * cs[e] + p * sn[e]; o[e] = r * osc; }
                    if (act) st16(dst + (size_t)row * 3072 + head * 192 + sub * 8, pack8(o));
                }
            }
        }
        for (int pass = 0; pass < 4; ++pass) {
            __syncthreads();
#pragma unroll
            for (int k = 0; k < 4; ++k) { const int idx = tid + 512 * k, r = idx >> 6, c = idx & 63, hl = c >> 4, cc = c & 15;
                *(LAS u32x4*)(lds + r * TP_PITCH + 16 * c) = ld16(KVRAW + (size_t)(s0 + r) * 4096 + (4 * pass + hl) * 256 + 128 + 8 * cc); }
            __syncthreads();
            tp_store(lds, VAT + (size_t)(512 * pass) * SEQ, s0, tid);
        }
        __syncthreads();
    }
}

namespace att {
__device__ __forceinline__ int swap23(int i) { return (i & ~12) | ((i & 4) << 1) | ((i & 8) >> 1); }
__device__ __forceinline__ void glds16(const void* gsrc, unsigned lds_dst) { unsigned keep;
    asm volatile("s_mov_b32 %0, m0\n\ts_mov_b32 m0, %2\n\ts_nop 0\n\tglobal_load_lds_dwordx4 %1, off\n\ts_mov_b32 m0, %0" : "=&s"(keep) : "v"(gsrc), "s"(lds_dst) : "memory"); }
#define ATT_WAIT_BAR() asm volatile("s_waitcnt vmcnt(0) lgkmcnt(0)\n\ts_barrier" ::: "memory")
__device__ __forceinline__ int crow(int r, int hi) { return (r & 3) + 8 * (r >> 2) + 4 * hi; }

#define ATT_SB() do { asm volatile("" ::: "memory"); __builtin_amdgcn_sched_barrier(0); } while (0)
template <int ND_A, int ND_B>
__device__ __forceinline__ bf16x8 frag_load(const LAS unsigned char* kA, const LAS unsigned char* kB, const LAS unsigned char* vt, int e, int kb, int r32, int xk, int xv) {
    constexpr int ND = ND_A + ND_B;
    if (e < ND_A) return *(const LAS bf16x8*)(kA + (32 * kb + r32) * 256 + (((2 * e) ^ xk) << 4));
    if (e < ND) return *(const LAS bf16x8*)(kB + (32 * kb + r32) * 128 + (((2 * (e - ND_A)) ^ xv) << 4));
    const int db = (e - ND) >> 1, ss = (e - ND) & 1;
    return *(const LAS bf16x8*)(vt + (32 * db + r32) * 128 + (((4 * kb + 2 * ss) ^ xv) << 4));
}
template <int ND_A, int ND_B, int NDB, int PD>
__device__ __forceinline__ void tile_compute(const bf16x8 (&fpre)[PD], const LAS unsigned char* kA, const LAS unsigned char* kB, const LAS unsigned char* vt, const bf16x8* qf, f32x16* o, float& lsum, int r32, int hi) {
    constexpr int ND = ND_A + ND_B, TOT = ND + 2 * NDB;
    bf16x8 f[2][TOT + PD];
#pragma unroll
    for (int i = 0; i < PD; ++i) f[0][i] = fpre[i];
    const int r32in = r32;
#pragma unroll
    for (int kb = 0; kb < 2; ++kb) {
        int r32 = r32in; asm volatile("" : "+v"(r32));
        const int xk = (r32 & 15) ^ hi, xv = ((r32 >> 1) & 7) ^ hi;
        f32x16 s = {0.f, 0.f, 0.f, 0.f, 0.f, 0.f, 0.f, 0.f, 0.f, 0.f, 0.f, 0.f, 0.f, 0.f, 0.f, 0.f};
#pragma unroll
        for (int e = 0; e < ND; ++e) {
            f[kb][e + PD] = frag_load<ND_A, ND_B>(kA, kB, vt, e + PD, kb, r32, xk, xv);
            s = __builtin_amdgcn_mfma_f32_32x32x16_bf16(f[kb][e], qf[e], s, 0, 0, 0);
            ATT_SB();
        }
        float la = 0.f, lb = 0.f; u32x4 w0, w1;
        { const float p0 = __builtin_amdgcn_exp2f(s[0]), p1 = __builtin_amdgcn_exp2f(s[1]), p2 = __builtin_amdgcn_exp2f(s[2]), p3 = __builtin_amdgcn_exp2f(s[3]); la += p0 + p2; lb += p1 + p3; w0.x = pg8::pk_bf16(p0, p1); w0.y = pg8::pk_bf16(p2, p3); }
        { const float p0 = __builtin_amdgcn_exp2f(s[4]), p1 = __builtin_amdgcn_exp2f(s[5]), p2 = __builtin_amdgcn_exp2f(s[6]), p3 = __builtin_amdgcn_exp2f(s[7]); la += p0 + p2; lb += p1 + p3; w0.z = pg8::pk_bf16(p0, p1); w0.w = pg8::pk_bf16(p2, p3); }
        { const float p0 = __builtin_amdgcn_exp2f(s[8]), p1 = __builtin_amdgcn_exp2f(s[9]), p2 = __builtin_amdgcn_exp2f(s[10]), p3 = __builtin_amdgcn_exp2f(s[11]); la += p0 + p2; lb += p1 + p3; w1.x = pg8::pk_bf16(p0, p1); w1.y = pg8::pk_bf16(p2, p3); }
        { const float p0 = __builtin_amdgcn_exp2f(s[12]), p1 = __builtin_amdgcn_exp2f(s[13]), p2 = __builtin_amdgcn_exp2f(s[14]), p3 = __builtin_amdgcn_exp2f(s[15]); la += p0 + p2; lb += p1 + p3; w1.z = pg8::pk_bf16(p0, p1); w1.w = pg8::pk_bf16(p2, p3); }
        lsum += la + lb;
        const bf16x8 pb0 = __builtin_bit_cast(bf16x8, w0), pb1 = __builtin_bit_cast(bf16x8, w1);
        ATT_SB();
#pragma unroll
        for (int e = ND; e < TOT; ++e) {
            if (e + PD < TOT) f[kb][e + PD] = frag_load<ND_A, ND_B>(kA, kB, vt, e + PD, kb, r32, xk, xv);
            else if (kb == 0) f[1][e + PD - TOT] = frag_load<ND_A, ND_B>(kA, kB, vt, e + PD - TOT, 1, r32, xk, xv);
            const int db = (e - ND) >> 1;
            o[db] = __builtin_amdgcn_mfma_f32_32x32x16_bf16(f[kb][e], ((e - ND) & 1) ? pb1 : pb0, o[db], 0, 0, 0);
            ATT_SB();
        }
    }
}

#ifndef MLA_PD
#define MLA_PD 4
#endif
template <int BUF>
__device__ __forceinline__ bf16x8 mla_frag(const LAS unsigned char* const (&ka)[12], const LAS unsigned char* const (&va)[4], int e, int kb) {
    if (e < 8) return *(const LAS bf16x8*)(ka[e] + BUF * 40960 + kb * 8192);
    if (e < 12) return *(const LAS bf16x8*)(ka[e] + BUF * 40960 + kb * 4096);
    return *(const LAS bf16x8*)(va[2 * kb + ((e - 12) & 1)] + BUF * 40960 + ((e - 12) >> 1) * 4096);
}
template <int BUF>
__device__ __forceinline__ void mla_tile(const bf16x8 (&fpre)[MLA_PD], const LAS unsigned char* const (&ka)[12], const LAS unsigned char* const (&va)[4], const bf16x8* qf, f32x16* o, float& lsum) {
    constexpr int ND = 12, TOT = 20, PD = MLA_PD;
    bf16x8 f[2][TOT + PD];
#pragma unroll
    for (int i = 0; i < PD; ++i) f[0][i] = fpre[i];
#pragma unroll
    for (int kb = 0; kb < 2; ++kb) {
        f32x16 s = {0.f, 0.f, 0.f, 0.f, 0.f, 0.f, 0.f, 0.f, 0.f, 0.f, 0.f, 0.f, 0.f, 0.f, 0.f, 0.f};
#pragma unroll
        for (int e = 0; e < ND; ++e) {
            f[kb][e + PD] = mla_frag<BUF>(ka, va, e + PD, kb);
            s = __builtin_amdgcn_mfma_f32_32x32x16_bf16(f[kb][e], qf[e], s, 0, 0, 0);
            ATT_SB();
        }
        float la = 0.f, lb = 0.f; u32x4 w0, w1;
        { const float p0 = __builtin_amdgcn_exp2f(s[0]), p1 = __builtin_amdgcn_exp2f(s[1]), p2 = __builtin_amdgcn_exp2f(s[2]), p3 = __builtin_amdgcn_exp2f(s[3]); la += p0 + p2; lb += p1 + p3; w0.x = pg8::pk_bf16(p0, p1); w0.y = pg8::pk_bf16(p2, p3); }
        { const float p0 = __builtin_amdgcn_exp2f(s[4]), p1 = __builtin_amdgcn_exp2f(s[5]), p2 = __builtin_amdgcn_exp2f(s[6]), p3 = __builtin_amdgcn_exp2f(s[7]); la += p0 + p2; lb += p1 + p3; w0.z = pg8::pk_bf16(p0, p1); w0.w = pg8::pk_bf16(p2, p3); }
        { const float p0 = __builtin_amdgcn_exp2f(s[8]), p1 = __builtin_amdgcn_exp2f(s[9]), p2 = __builtin_amdgcn_exp2f(s[10]), p3 = __builtin_amdgcn_exp2f(s[11]); la += p0 + p2; lb += p1 + p3; w1.x = pg8::pk_bf16(p0, p1); w1.y = pg8::pk_bf16(p2, p3); }
        { const float p0 = __builtin_amdgcn_exp2f(s[12]), p1 = __builtin_amdgcn_exp2f(s[13]), p2 = __builtin_amdgcn_exp2f(s[14]), p3 = __builtin_amdgcn_exp2f(s[15]); la += p0 + p2; lb += p1 + p3; w1.z = pg8::pk_bf16(p0, p1); w1.w = pg8::pk_bf16(p2, p3); }
        lsum += la + lb;
        const bf16x8 pb0 = __builtin_bit_cast(bf16x8, w0), pb1 = __builtin_bit_cast(bf16x8, w1);
        ATT_SB();
#pragma unroll
        for (int e = ND; e < TOT; ++e) {
            if (e + PD < TOT) f[kb][e + PD] = mla_frag<BUF>(ka, va, e + PD, kb);
            else if (kb == 0) f[1][e + PD - TOT] = mla_frag<BUF>(ka, va, e + PD - TOT, 1);
            const int db = (e - ND) >> 1;
            o[db] = __builtin_amdgcn_mfma_f32_32x32x16_bf16(f[kb][e], ((e - ND) & 1) ? pb1 : pb0, o[db], 0, 0, 0);
            ATT_SB();
        }
    }
}

template <int ND_A, int ND_B, int NDB>
__device__ __forceinline__ void tile_compute_simple(const LAS unsigned char* kA, const LAS unsigned char* kB, const LAS unsigned char* vt, const bf16x8* qf, f32x16* o, float& lsum, int r32, int hi) {
    static_assert(ND_B == 0, "simple form: one K region");
    const int xk = (r32 & 15) ^ hi, xv = ((r32 >> 1) & 7) ^ hi;
#pragma unroll
    for (int kb = 0; kb < 2; ++kb) {
        f32x16 s = {0.f, 0.f, 0.f, 0.f, 0.f, 0.f, 0.f, 0.f, 0.f, 0.f, 0.f, 0.f, 0.f, 0.f, 0.f, 0.f};
        const LAS unsigned char* ka = kA + (32 * kb + r32) * 256;
        bf16x8 a = *(const LAS bf16x8*)(ka + ((0 ^ xk) << 4));
#pragma unroll
        for (int d0 = 0; d0 < ND_A; ++d0) { bf16x8 an = a; if (d0 + 1 < ND_A) an = *(const LAS bf16x8*)(ka + (((2 * (d0 + 1)) ^ xk) << 4));
            s = __builtin_amdgcn_mfma_f32_32x32x16_bf16(a, qf[d0], s, 0, 0, 0); a = an; __builtin_amdgcn_sched_barrier(0); }
        const LAS unsigned char* vr = vt + r32 * 128;
        bf16x8 v0 = *(const LAS bf16x8*)(vr + (((4 * kb) ^ xv) << 4)), v1 = *(const LAS bf16x8*)(vr + (((4 * kb + 2) ^ xv) << 4));
        float p[16];
#pragma unroll
        for (int r = 0; r < 16; ++r) { p[r] = __builtin_amdgcn_exp2f(s[r]); lsum += p[r]; }
        u32x4 w0, w1; w0.x = pg8::pk_bf16(p[0], p[1]); w0.y = pg8::pk_bf16(p[2], p[3]); w0.z = pg8::pk_bf16(p[4], p[5]); w0.w = pg8::pk_bf16(p[6], p[7]);
        w1.x = pg8::pk_bf16(p[8], p[9]); w1.y = pg8::pk_bf16(p[10], p[11]); w1.z = pg8::pk_bf16(p[12], p[13]); w1.w = pg8::pk_bf16(p[14], p[15]);
        const bf16x8 pb0 = __builtin_bit_cast(bf16x8, w0), pb1 = __builtin_bit_cast(bf16x8, w1);
        __builtin_amdgcn_sched_barrier(0);
#pragma unroll
        for (int db = 0; db < NDB; ++db) { bf16x8 n0 = v0, n1 = v1;
            if (db + 1 < NDB) { n0 = *(const LAS bf16x8*)(vr + (db + 1) * 4096 + (((4 * kb) ^ xv) << 4)); n1 = *(const LAS bf16x8*)(vr + (db + 1) * 4096 + (((4 * kb + 2) ^ xv) << 4)); }
            o[db] = __builtin_amdgcn_mfma_f32_32x32x16_bf16(v0, pb0, o[db], 0, 0, 0); o[db] = __builtin_amdgcn_mfma_f32_32x32x16_bf16(v1, pb1, o[db], 0, 0, 0); v0 = n0; v1 = n1; __builtin_amdgcn_sched_barrier(0); }
    }
}

constexpr int MLA_STAGE = 40960, DIFF_STAGE = 65536;
#ifndef DIFF_PD
#define DIFF_PD 0
#endif
__device__ __forceinline__ void glds16s(unsigned voff, const void* sbase, unsigned lds_dst) { unsigned keep;
    asm volatile("s_nop 3\n\ts_mov_b32 %0, m0\n\ts_mov_b32 m0, %3\n\ts_nop 0\n\tglobal_load_lds_dwordx4 %1, %2\n\ts_mov_b32 m0, %0" : "=&s"(keep) : "v"(voff), "s"(sbase), "s"(lds_dst) : "memory"); }
__device__ __forceinline__ void mla_stage(const char* Kb, const char* Vb, int t, unsigned dst, int wave, int lane) {
    asm volatile("" : "+v"(lane));
    const unsigned q = lane >> 4, g3 = lane >> 3;
    const unsigned Bn = ((lane & 15) ^ q) * 16, Br = ((lane & 7) ^ q) * 16;
    const int w0 = wave & 1, w1 = (wave >> 1) & 1, w2 = wave >> 2;
    const char* kbase = Kb + (size_t)(64 * t + 32 * w2 + 16 * w1 + 4 * w0) * 6144;
#pragma unroll
    for (int j = 0; j < 2; ++j)
        glds16s(q * 6144 + (Bn ^ (unsigned)(128 * w0 + 64 * j)), kbase + (size_t)(8 * j) * 6144, (unsigned)__builtin_amdgcn_readfirstlane(dst + (2 * wave + j) * 1024));
    glds16s((8 * (lane >> 5) + (g3 & 3)) * 6144 + (Br ^ (unsigned)(64 * w0)), kbase + 256, (unsigned)__builtin_amdgcn_readfirstlane(dst + 16384 + wave * 1024));
    const char* vbase = Vb + (size_t)(2 * wave) * 8 * (SEQ * 2) + t * 128;
#pragma unroll
    for (int j = 0; j < 2; ++j)
        glds16s(g3 * (SEQ * 2) + (Br ^ (unsigned)(64 * j)), vbase + (size_t)j * 8 * (SEQ * 2), (unsigned)__builtin_amdgcn_readfirstlane(dst + 24576 + (2 * wave + j) * 1024));
}
__device__ __forceinline__ void diff_stage(const char* Kb, const char* Vb, int t, unsigned dst, int wave, int lane) {
    asm volatile("" : "+v"(lane));
    const unsigned q = lane >> 4;
    if (wave < 4) {
        const unsigned A = q * 4096, B = ((lane & 15) ^ q) * 16;
        const char* base = Kb + (wave >> 1) * 256 + (size_t)(64 * t + 32 * (wave & 1)) * 4096;
#pragma unroll
        for (int k = 0; k < 8; ++k) { const int Kk = 16 * (k >> 2) + 8 * (k & 1) + 4 * ((k >> 1) & 1);
            glds16s(A + (B ^ (unsigned)(64 * (k & 3))), base + (size_t)Kk * 4096, (unsigned)__builtin_amdgcn_readfirstlane(dst + (wave * 8 + k) * 1024)); }
    } else {
        const unsigned A = (lane >> 3) * (SEQ * 2), B = ((lane & 7) ^ q) * 16;
        const char* base = Vb + (size_t)(wave - 4) * 64 * (SEQ * 2) + t * 128;
#pragma unroll
        for (int k = 0; k < 8; ++k)
            glds16s(A + (B ^ (unsigned)(64 * (k & 1))), base + (size_t)k * 8 * (SEQ * 2), (unsigned)__builtin_amdgcn_readfirstlane(dst + (wave * 8 + k) * 1024));
    }
}

__device__ __forceinline__ void mla_unit(int h, int qb, const bf16* QA, const bf16* KA, const bf16* VAT, bf16* OC, LAS unsigned char* lds, int wave, int lane) {
    const int r32 = lane & 31, hi = lane >> 5; const unsigned lds0 = (unsigned)(uintptr_t)lds;
    const int row = 256 * qb + 32 * wave + r32, cw = 4 * qb + (wave >> 1), NT = 4 * qb + 4;
    const char* Kb = (const char*)(KA + h * 192); const char* Vb = (const char*)(VAT + (size_t)h * 128 * SEQ);
    mla_stage(Kb, Vb, 0, lds0, wave, lane);
    bf16x8 qf[12];
#pragma unroll
    for (int d0 = 0; d0 < 12; ++d0) qf[d0] = *(const bf16x8*)(QA + (size_t)row * 3072 + h * 192 + 16 * d0 + 8 * hi);
#pragma unroll
    for (int d0 = 0; d0 < 12; ++d0) asm volatile("" : "+v"(qf[d0]));
    f32x16 o[4];
#pragma unroll
    for (int db = 0; db < 4; ++db)
#pragma unroll
        for (int r = 0; r < 16; ++r) o[db][r] = 0.f;
    float lsum = 0.f;
    const LAS unsigned char* ka[12]; const LAS unsigned char* va[4];
    { const int xk = (r32 & 15) ^ hi, xv = ((r32 >> 1) & 7) ^ hi;
#pragma unroll
      for (int d0 = 0; d0 < 8; ++d0) ka[d0] = lds + r32 * 256 + (((2 * d0) ^ xk) << 4);
#pragma unroll
      for (int d0 = 0; d0 < 4; ++d0) ka[8 + d0] = lds + 16384 + r32 * 128 + (((2 * d0) ^ xv) << 4);
#pragma unroll
      for (int i = 0; i < 4; ++i) va[i] = lds + 24576 + r32 * 128 + (((4 * (i >> 1) + 2 * (i & 1)) ^ xv) << 4); }
#define MLA_BODY(BUF_, T_) do { const int t_ = (T_); ATT_WAIT_BAR(); bf16x8 fp[MLA_PD]; \
        if (t_ <= cw) { _Pragma("unroll") for (int i_ = 0; i_ < MLA_PD; ++i_) fp[i_] = mla_frag<BUF_>(ka, va, i_, 0); } \
        if (t_ + 1 < NT) mla_stage(Kb, Vb, t_ + 1, lds0 + (1 - (BUF_)) * MLA_STAGE, wave, lane); \
        if (t_ <= cw) mla_tile<BUF_>(fp, ka, va, qf, o, lsum); } while (0)
    for (int t = 0; t < NT; t += 2) { MLA_BODY(0, t); MLA_BODY(1, t + 1); }
#undef MLA_BODY
    lsum += __shfl_xor(lsum, 32);
    const float inv = 1.0f / lsum;
    bf16* orow = OC + (size_t)row * 4096 + h * 128;
#pragma unroll
    for (int db = 0; db < 4; ++db)
#pragma unroll
        for (int g4 = 0; g4 < 4; ++g4) { u32x2 w; w.x = pg8::pk_bf16(o[db][4 * g4] * inv, o[db][4 * g4 + 1] * inv); w.y = pg8::pk_bf16(o[db][4 * g4 + 2] * inv, o[db][4 * g4 + 3] * inv);
            *(u32x2*)(orow + 32 * db + 8 * g4 + 4 * hi) = w; }
    ATT_WAIT_BAR();
}

__device__ __forceinline__ void diff_unit(int h, int j, float lam, const bf16* QD, const bf16* KD, const bf16* VDT, const float* gsub, bf16* OC, LAS unsigned char* lds, int wave, int lane) {
    const int r32 = lane & 31, hi = lane >> 5, m = wave >> 2, qs = wave & 3; const unsigned lds0 = (unsigned)(uintptr_t)lds;
    const int row = 128 * j + 32 * qs + r32, cw = 2 * j + (qs >> 1), NT = 2 * j + 2;
    const char* Kb = (const char*)(KD + (h * 2) * 128); const char* Vb = (const char*)(VDT + (size_t)h * 256 * SEQ);
    diff_stage(Kb, Vb, 0, lds0, wave, lane);
    bf16x8 qf[8];
#pragma unroll
    for (int d0 = 0; d0 < 8; ++d0) qf[d0] = *(const bf16x8*)(QD + (size_t)row * 2048 + (h * 2 + m) * 128 + 16 * d0 + 8 * hi);
#pragma unroll
    for (int d0 = 0; d0 < 8; ++d0) asm volatile("" : "+v"(qf[d0]));
    f32x16 o[8];
#pragma unroll
    for (int db = 0; db < 8; ++db)
#pragma unroll
        for (int r = 0; r < 16; ++r) o[db][r] = 0.f;
    float lsum = 0.f;
    for (int t = 0; t < NT; ++t) {
        ATT_WAIT_BAR();
        const LAS unsigned char* sb = lds + (t & 1) * DIFF_STAGE; int r32o = r32; asm volatile("" : "+v"(r32o));
#if DIFF_PD == 0
        if (t + 1 < NT) diff_stage(Kb, Vb, t + 1, lds0 + ((t + 1) & 1) * DIFF_STAGE, wave, lane);
        if (t <= cw) tile_compute_simple<8, 0, 8>(sb + m * 16384, sb, sb + 32768, qf, o, lsum, r32o, hi);
#else
        bf16x8 fp[DIFF_PD];
        if (t <= cw) {
#pragma unroll
            for (int i = 0; i < DIFF_PD; ++i) fp[i] = frag_load<8, 0>(sb + m * 16384, sb, sb + 32768, i, 0, r32o, (r32o & 15) ^ hi, ((r32o >> 1) & 7) ^ hi); }
        if (t + 1 < NT) diff_stage(Kb, Vb, t + 1, lds0 + ((t + 1) & 1) * DIFF_STAGE, wave, lane);
        if (t <= cw) tile_compute<8, 0, 8, DIFF_PD>(fp, sb + m * 16384, sb, sb + 32768, qf, o, lsum, r32o, hi);
#endif
    }
    lsum += __shfl_xor(lsum, 32);
    ATT_WAIT_BAR();
    LAS float* X = (LAS float*)lds;
    if (m == 1) { const float f = lam / lsum;
#pragma unroll
        for (int db = 0; db < 8; ++db)
#pragma unroll
            for (int r = 0; r < 16; ++r) X[(32 * db + crow(r, hi)) * 128 + 32 * qs + r32] = o[db][r] * f; }
    ATT_WAIT_BAR();
    if (m == 0) { const float inv = 1.0f / lsum; float ss = 0.f;
#pragma unroll
        for (int db = 0; db < 8; ++db)
#pragma unroll
            for (int r = 0; r < 16; ++r) { const float v = o[db][r] * inv - X[(32 * db + crow(r, hi)) * 128 + 32 * qs + r32]; o[db][r] = v; ss += v * v; }
        ss += __shfl_xor(ss, 32);
        const float sc = (1.0f - LAMBDA_INIT) / sqrtf(ss * (1.f / 256.f) + EPS);
        bf16* orow = OC + (size_t)row * 4096 + 2048 + h * 256;
#pragma unroll
        for (int db = 0; db < 8; ++db)
#pragma unroll
            for (int g4 = 0; g4 < 4; ++g4) { const int dv0 = 32 * db + 8 * g4 + 4 * hi; const f32x4 g = *(const f32x4*)(gsub + dv0);
                u32x2 w; w.x = pg8::pk_bf16(o[db][4 * g4] * sc * g.x, o[db][4 * g4 + 1] * sc * g.y); w.y = pg8::pk_bf16(o[db][4 * g4 + 2] * sc * g.z, o[db][4 * g4 + 3] * sc * g.w);
                *(u32x2*)(orow + dv0) = w; } }
    ATT_WAIT_BAR();
}
}

__device__ __forceinline__ int fresh_lane() { int l = (int)__builtin_amdgcn_mbcnt_hi(~0u, __builtin_amdgcn_mbcnt_lo(~0u, 0u)); asm volatile("" : "+v"(l)); return l; }
constexpr int I_IN = (DM / 64) * (DIN / 32), I_UQ = (768 / 64) * (3072 / 32), I_UKV = (512 / 64) * (4096 / 32), I_O = (DM / 64) * (DM / 32), I_G = (DM / 64) * (DFF / 32), I_D = (DFF / 64) * (DM / 32);
constexpr int NG1 = 13000, ND8 = 19000, NU3 = 8000, SPARE1 = 16, SPARE8 = 5;
static_assert(NG1 <= I_G && ND8 <= I_D, "deferred item counts");
__global__ void __launch_bounds__(NWAVES * 64) fwd_kernel(Args A) {
    extern __shared__ __attribute__((aligned(16))) unsigned char lds_raw[];
    LAS unsigned char* lds = (LAS unsigned char*)lds_raw;
    cg::grid_group grid = cg::this_grid();
    const int wave = __builtin_amdgcn_readfirstlane((int)threadIdx.x >> 6);
    const int lane = (int)__builtin_amdgcn_mbcnt_hi(~0u, __builtin_amdgcn_mbcnt_lo(~0u, 0u)), tid = wave * 64 + lane;
    const int G = gridDim.x, bx = blockIdx.x; const int vcu = (G % 8 == 0) ? (bx % 8) * (G / 8) + bx / 8 : bx;
    unsigned char* ws = A.ws;
    const int lo = A.ph_lo, hi = A.ph_hi;
#define IN(k) (lo <= (k) && (k) < hi)
#ifndef PROBE_MASK
#define PROBE_MASK 0
#endif
#define REPS(k) for (int rep_ = 0; rep_ < (((PROBE_MASK >> (k)) & 1) ? 2 : 1); ++rep_)
    volatile LAS unsigned* bst = (volatile LAS unsigned*)(lds + LDS_BYTES - 64);
    if (tid < 2) bst[tid] = 0u;
    __syncthreads();
    XcdBarrier bar; bar.bar = (unsigned*)(ws + WS_BAR); bar.x = 0; bar.st = bst;
    const bool t0 = (tid == 0);
    if (hi - lo > 1) bar = xcd_barrier_post((unsigned*)(ws + WS_BAR), bst, t0);
#define SEAM(k) do { if (IN(k) && IN((k) + 1)) { if ((k) == 0) grid.sync(); else xcd_barrier(bar, t0); } } while (0)
    bf16* XN = (bf16*)(ws + WS_XN);

    if (IN(0)) REPS(0) {
        LAS float* scr = (LAS float*)(lds + wave * 16384);
        const int gw = vcu * NWAVES + wave, NGW = G * NWAVES;
        const int ng1 = (G >= 64) ? NG1 : 0, nd8 = (G >= 64) ? ND8 : 0, nu3 = (G >= 64) ? NU3 : 0, wo0 = (G >= 64) ? 0 : I_O;
        {
            int base = 0;
#define P0_STREAM(W_, K_, N_, WT_, MODE_, FIRST_, CNT_) do { const int b_ = ((gw - base) % NGW + NGW) % NGW; \
                conv_stream(W_, K_, N_, WT_, MODE_, scr, (FIRST_) + b_, (FIRST_) + (CNT_), NGW, lane); base += (CNT_); } while (0)
            P0_STREAM(A.in[2], DM, DIN, (bf16*)(ws + WS_WIN), 0, 0, I_IN);
            P0_STREAM(A.in[5], 768, 3072, (bf16*)(ws + WS_WUQ), 0, 0, I_UQ);
            P0_STREAM(A.in[6], 512, 4096, (bf16*)(ws + WS_WUKV), 0, 0, I_UKV);
            P0_STREAM(A.in[16], DM, DM, (bf16*)(ws + WS_WO), 0, 0, wo0);
            P0_STREAM(A.in[18], DM, DFF, (bf16*)(ws + WS_WGU), 1, ng1, I_G - ng1);
            P0_STREAM(A.in[19], DM, DFF, (bf16*)(ws + WS_WGU), 2, nu3, I_G - nu3);
            P0_STREAM(A.in[20], DFF, DM, (bf16*)(ws + WS_WDN), 0, nd8, I_D - nd8);
#undef P0_STREAM
        }
        { u32x4* pz = (u32x4*)(ws + WS_WIN + (size_t)DIN * DM * 2); const int n16 = (ZLD - DIN) * DM * 2 / 16; const u32x4 z4 = {0u, 0u, 0u, 0u};
            for (int i = vcu * 512 + tid; i < n16; i += G * 512) pz[i] = z4; }
        for (int mrow = gw; mrow < SEQ; mrow += NGW) rms_row_4096(A.in[0] + (size_t)mrow * DM, A.in[1], XN + (size_t)mrow * DM, lane);
    }
    SEAM(0);
    if (IN(1)) REPS(1) {
        const int spare = (G >= 64) ? SPARE1 : 0, Gg = G - spare;
        if (bx < Gg) {
            pg8::Gemm g{XN, (const bf16*)(ws + WS_WIN), SEQ, ZLD, DM}; pg8::StaticOrder S; S.init(SEQ, ZLD, Gg, bx);
            pg8::EpiBf16S E{(bf16*)(ws + WS_Z), ZLD};
            pg8::gemm_phase<pg8::EpiBf16S, pg8::StaticOrder, true, true>(lds, g, S, E, tid);
        } else {
            LAS float* scr = (LAS float*)(lds + wave * 16384);
            const int sw = (bx - Gg) * NWAVES + wave, ns = spare * NWAVES;
            conv_stream(A.in[16], DM, DM, (bf16*)(ws + WS_WO), 0, scr, sw, I_O, ns, lane);
            conv_stream(A.in[18], DM, DFF, (bf16*)(ws + WS_WGU), 1, scr, sw, NG1, ns, lane);
        }
    }
    SEAM(1);
    if (IN(2)) REPS(2) p2_phase(A, lds, vcu, G, tid, wave, lane);
    SEAM(2);
    if (IN(3)) REPS(3) {
        { pg8::Gemm g{(const bf16*)(ws + WS_CQN), (const bf16*)(ws + WS_WUQ), SEQ, 3072, 768}; pg8::StaticOrder S; S.init(SEQ, 3072, G, G - 1 - bx);
          pg8::EpiBf16S E{(bf16*)(ws + WS_QRAW), 3072};
          pg8::gemm_phase<pg8::EpiBf16S, pg8::StaticOrder, true, true>(lds, g, S, E, tid); }
        { pg8::Gemm g{(const bf16*)(ws + WS_CKVN), (const bf16*)(ws + WS_WUKV), SEQ, 4096, 512}; pg8::StaticOrder S; S.init(SEQ, 4096, G, bx);
          pg8::EpiBf16S E{(bf16*)(ws + WS_KVRAW), 4096};
          pg8::gemm_phase<pg8::EpiBf16S, pg8::StaticOrder, true, true>(lds, g, S, E, tid); }
        if (G >= 64 && bx < G / 2)
            conv_stream(A.in[19], DM, DFF, (bf16*)(ws + WS_WGU), 2, (LAS float*)(lds + wave * 16384), bx * NWAVES + wave, NU3, (G / 2) * NWAVES, lane);
    }
    SEAM(3);
    if (IN(4)) REPS(4) p4_phase(A, lds, vcu, G, tid, wave, lane);
    SEAM(4);
    if (IN(5)) {
        float lam;
        { const float* q1 = A.in[11]; const float* k1 = A.in[12]; const float* q2 = A.in[13]; const float* k2 = A.in[14];
          const float s1 = wave_sum(q1[lane] * k1[lane] + q1[lane + 64] * k1[lane + 64]), s2 = wave_sum(q2[lane] * k2[lane] + q2[lane + 64] * k2[lane + 64]);
          lam = __uint_as_float(__builtin_amdgcn_readfirstlane(__float_as_uint(expf(s1) - expf(s2) + LAMBDA_INIT))); }
        const bf16* QA = (const bf16*)(ws + WS_QA); const bf16* KA = (const bf16*)(ws + WS_KA); const bf16* VAT = (const bf16*)(ws + WS_VAT);
        const bf16* QD = (const bf16*)(ws + WS_QD); const bf16* KD = (const bf16*)(ws + WS_KD); const bf16* VDT = (const bf16*)(ws + WS_VDT);
        bf16* OC = (bf16*)(ws + WS_OC);
        REPS(5) for (int p = vcu; p < 256; p += G) {
            { const int h = p >> 5, s = p & 31; att::diff_unit(h, 63 - s, lam, QD, KD, VDT, A.in[15], OC, lds, wave, lane); att::diff_unit(h, s, lam, QD, KD, VDT, A.in[15], OC, lds, wave, lane); }
            { const int h = p >> 4, s = p & 15; att::mla_unit(h, 31 - s, QA, KA, VAT, OC, lds, wave, lane); att::mla_unit(h, s, QA, KA, VAT, OC, lds, wave, lane); }
        }
    }
    SEAM(5);
    if (IN(6)) REPS(6) {
        pg8::Gemm g{(const bf16*)(ws + WS_OC), (const bf16*)(ws + WS_WO), SEQ, DM, DM}; pg8::StaticOrder S; S.init(SEQ, DM, G, bx);
        pg8::EpiResF32 E{A.in[0], A.out, DM};
        pg8::gemm_phase<pg8::EpiResF32, pg8::StaticOrder, true, true>(lds, g, S, E, wave * 64 + fresh_lane());
    }
    SEAM(6);
    if (IN(7)) REPS(7) {
        const int gw = vcu * NWAVES + wave, NGW = G * NWAVES;
        for (int mrow = gw; mrow < SEQ; mrow += NGW) rms_row_4096(A.out + (size_t)mrow * DM, A.in[17], XN + (size_t)mrow * DM, fresh_lane());
    }
    SEAM(7);
    if (IN(8)) REPS(8) {
        const int spare = (G >= 64) ? SPARE8 : 0, Gg = G - spare;
        if (bx < Gg) {
            pg8::Gemm g{XN, (const bf16*)(ws + WS_WGU), SEQ, 2 * DFF, DM}; pg8::StaticOrder S; S.init(SEQ, 2 * DFF, Gg, bx);
            pg8::EpiSwiGLU E{(bf16*)(ws + WS_ACT), DFF};
            pg8::gemm_phase<pg8::EpiSwiGLU, pg8::StaticOrder, true, true>(lds, g, S, E, wave * 64 + fresh_lane());
        } else {
            LAS float* scr = (LAS float*)(lds + wave * 16384);
            conv_stream(A.in[20], DFF, DM, (bf16*)(ws + WS_WDN), 0, scr, (bx - Gg) * NWAVES + wave, ND8, spare * NWAVES, fresh_lane());
        }
    }
    SEAM(8);
    if (IN(9)) REPS(9) {
        pg8::Gemm g{(const bf16*)(ws + WS_ACT), (const bf16*)(ws + WS_WDN), SEQ, DM, DFF}; pg8::StaticOrder S; S.init(SEQ, DM, G, bx);
        pg8::EpiResF32 E{A.out, A.out, DM};
        pg8::gemm_phase<pg8::EpiResF32, pg8::StaticOrder, true, true>(lds, g, S, E, wave * 64 + fresh_lane());
    }
#undef IN
#undef SEAM
}

#ifndef MK_PER_PHASE
#define MK_PER_PHASE 0
#endif
constexpr int N_PHASES = 10;
extern "C" void kernel_launch(void* const* d_in, const int* in_sizes, int n_in, void* d_out, int out_size, void* d_ws, size_t ws_size, hipStream_t stream) {
    static int grid = 0;
    if (grid == 0) {
        if (n_in != 21 || in_sizes[0] != SEQ * DM || out_size != SEQ * DM || ws_size < WS_END) { fprintf(stderr, "kernel_launch: unexpected shapes / workspace (n_in %d, ws %zu, need %zu)\n", n_in, ws_size, (size_t)WS_END); grid = -1; return; }
        int dev = 0, cus = 0, per_cu = 0;
        if (hipGetDevice(&dev) != hipSuccess || hipDeviceGetAttribute(&cus, hipDeviceAttributeMultiprocessorCount, dev) != hipSuccess) { grid = -1; return; }
        if (hipFuncSetAttribute((const void*)fwd_kernel, hipFuncAttributeMaxDynamicSharedMemorySize, LDS_BYTES) != hipSuccess) { fprintf(stderr, "kernel_launch: hipFuncSetAttribute failed\n"); grid = -1; return; }
        if (hipOccupancyMaxActiveBlocksPerMultiprocessor(&per_cu, (const void*)fwd_kernel, NWAVES * 64, LDS_BYTES) != hipSuccess || per_cu < 1) { fprintf(stderr, "kernel_launch: occupancy query gave %d\n", per_cu); per_cu = 1; }
        (void)hipGetLastError();
        grid = cus * per_cu;
    }
    if (grid < 0) return;
    if (hipMemsetAsync((char*)d_ws + WS_BAR, 0, XCD_BAR_WORDS * 4, stream) != hipSuccess) { fprintf(stderr, "kernel_launch: hipMemsetAsync failed\n"); return; }
    Args a{};
    for (int i = 0; i < 21; ++i) a.in[i] = (const float*)d_in[i];
    a.out = (float*)d_out; a.ws = (unsigned char*)d_ws;
    for (int j = 0; j < 64; ++j) a.invf[j] = (float)std::pow(10000.0, -(double)j / 64.0);
#if MK_PER_PHASE
#ifndef HOST_REP_MASK
#define HOST_REP_MASK 0
#endif
    for (int ph = 0; ph < N_PHASES; ++ph) for (int rep = 0; rep < (((HOST_REP_MASK >> ph) & 1) ? 2 : 1); ++rep) { a.ph_lo = ph; a.ph_hi = ph + 1; hipLaunchKernelGGL(fwd_kernel, dim3(grid), dim3(NWAVES * 64), LDS_BYTES, stream, a); }
#else
    a.ph_lo = 0; a.ph_hi = N_PHASES;
    void* args[] = {&a};
    hipError_t e = hipLaunchCooperativeKernel((const void*)fwd_kernel, dim3(grid), dim3(NWAVES * 64), args, LDS_BYTES, stream);
    if (e != hipSuccess) fprintf(stderr, "kernel_launch: cooperative launch failed: %s (grid %d)\n", hipGetErrorString(e), grid);
#endif
}
```

```cpp
#include <hip/hip_runtime.h>
#include <hip/hip_cooperative_groups.h>
#include <cstdio>
#include <cstdint>
#include <cmath>
namespace cg = cooperative_groups;
namespace pg8 {
#define PG8_LAS __attribute__((address_space(3)))
typedef unsigned short bf16_t;
typedef short bf16x8 __attribute__((ext_vector_type(8)));
typedef float f32x4 __attribute__((ext_vector_type(4)));
typedef unsigned u32x4 __attribute__((ext_vector_type(4)));
constexpr int BM = 256, BK = 64, HALF = 128, HTB = HALF * BK * 2  , STAGE_BYTES = 8 * HTB, NXCD = 8, WGM = 8;

__host__ __device__ __forceinline__ int lds_byte(int r, int c) { const int st = (r >> 4) * 2 + (c >> 5), rr = r & 15, cc = c & 31, ob = rr * 64 + cc * 2; return st * 1024 + (ob ^ (((ob >> 9) & 1) << 5)); }
__host__ __device__ __forceinline__ void stage_rc(int b, int& R, int& C) { const int st = b / 1024, sb = b % 1024, swz = sb ^ (((sb >> 9) & 1) << 5); R = (st >> 1) * 16 + swz / 64; C = (st & 1) * 32 + (swz % 64) / 2; }
__host__ __device__ __forceinline__ int perm32(int rho) { const int n = rho >> 4, i = rho & 15; return 8 * (i >> 2) + 4 * n + (i & 3); }

struct Unit { int pm, pn; };
struct Gemm { const bf16_t* A; const bf16_t* Bt; int M, N, K; };

struct StaticOrder {
    int nM, nN, nwg, G, c;
    __host__ __device__ void init(int M, int N, int G_, int c_) { nM = M / BM; nN = N / BM; nwg = nM * nN; G = G_; c = c_; }
    __host__ __device__ bool next(int i, Unit& u) const {
        const long L = (long)i * G + c; if (L >= nwg) return false;
        int wgid = (int)L; { const int q = nwg / NXCD, r = nwg % NXCD, xcd = wgid % NXCD, off = wgid / NXCD; wgid = (xcd < r ? xcd * (q + 1) : r * (q + 1) + (xcd - r) * q) + off; }
        const int nig = WGM * nN, gid = wgid / nig, fm = gid * WGM, gsz = (nM - fm) < WGM ? (nM - fm) : WGM;
        u.pm = fm + ((wgid % nig) % gsz); u.pn = (wgid % nig) / gsz; return true;
    }
    __device__ __forceinline__ void a_ready(const Unit&) const {}
    __device__ __forceinline__ void done(const Unit&) const {}
};

__device__ __forceinline__ unsigned cvt_pk_bf16(float lo, float hi) { unsigned r; asm volatile("v_cvt_pk_bf16_f32 %0, %1, %2" : "=v"(r) : "v"(lo), "v"(hi)); return r; }
typedef float f32x2 __attribute__((ext_vector_type(2)));
template <class Epi, class Sched, bool ALIGN_EPI = false, bool SP2 = false>
__device__ __forceinline__ void gemm_phase(PG8_LAS unsigned char* lds, const Gemm g, const Sched& S, const Epi& E, const int tid_in) {
    const int tid = tid_in, wid = __builtin_amdgcn_readfirstlane(tid >> 6), lane = tid & 63, wr = wid >> 2, wc = wid & 3, fr = lane & 15, fq = lane >> 4;
    const int K = g.K, nt = K / BK;
    unsigned voffA[2], voffB[2];
#pragma unroll
    for (int i = 0; i < 2; ++i) { int R, C; stage_rc(tid * 16 + i * 8192, R, C); const int Rb = Epi::PERM ? ((R & ~31) + perm32(R & 31)) : R;
        voffA[i] = (unsigned)(R * K + C) * 2u; voffB[i] = (unsigned)(Rb * K + C) * 2u; }
    const size_t kstep = (size_t)(BK * 2);
    const size_t hstep = (size_t)HALF * K * 2;
    const size_t tstep = 2 * hstep;
    const unsigned ldsw = (unsigned)wid * 1024u;
    const int aoff = lds_byte(wr * 64 + fr, fq * 8), boff = lds_byte(wc * 32 + fr, fq * 8);
#define PG8_SA(b, h) (((b) * 2 + (h)) * HTB)
#define PG8_SB(b, h) ((4 + (b) * 2 + (h)) * HTB)
#define PG8_STAGE(bufoff, gbase, voff) do { _Pragma("unroll") for (int _i = 0; _i < 2; ++_i) \
        __builtin_amdgcn_global_load_lds((const unsigned*)((const char*)(gbase) + (voff)[_i]), (PG8_LAS unsigned*)(lds + (bufoff) + ldsw + _i * 8192), 16, 0, 0); } while (0)
#define PG8_LDA(dst, b, h) do { _Pragma("unroll") for (int m = 0; m < 4; ++m) _Pragma("unroll") for (int k = 0; k < 2; ++k) dst[m][k] = *(const PG8_LAS bf16x8*)(lds + PG8_SA(b, h) + aoff + m * 2048 + k * 1024); } while (0)
#define PG8_LDB(dst, b, h) do { _Pragma("unroll") for (int n = 0; n < 2; ++n) _Pragma("unroll") for (int k = 0; k < 2; ++k) dst[n][k] = *(const PG8_LAS bf16x8*)(lds + PG8_SB(b, h) + boff + n * 2048 + k * 1024); } while (0)
#define PG8_MMA(ai, bj, At, Bt) do { __builtin_amdgcn_s_setprio(1); _Pragma("unroll") for (int m = 0; m < 4; ++m) _Pragma("unroll") for (int n = 0; n < 2; ++n) _Pragma("unroll") for (int k = 0; k < 2; ++k) \
        acc[ai][bj][m][n] = __builtin_amdgcn_mfma_f32_16x16x32_bf16(Bt[n][k], At[m][k], acc[ai][bj][m][n], 0, 0, 0); __builtin_amdgcn_s_setprio(0); } while (0)
#define PG8_WAIT_V(n) asm volatile("s_waitcnt vmcnt(" #n ")" ::: "memory")
#define PG8_WAIT_L(n) asm volatile("s_waitcnt lgkmcnt(" #n ")" ::: "memory")
#define PG8_BAR __builtin_amdgcn_s_barrier()
#define PG8_SCHED __builtin_amdgcn_sched_barrier(0)
    Unit cur, nxt; int ui = 0;
    if (!S.next(0, cur)) return;
    f32x4 acc[2][2][4][2];
#pragma unroll
    for (int a = 0; a < 2; ++a)
#pragma unroll
        for (int b = 0; b < 2; ++b)
#pragma unroll
            for (int m = 0; m < 4; ++m)
#pragma unroll
                for (int n = 0; n < 2; ++n) acc[a][b][m][n] = (f32x4){0.f, 0.f, 0.f, 0.f};
    bf16x8 At[4][2], B0[2][2], B1[2][2];
    const char* cA = (const char*)g.A + (size_t)cur.pm * tstep; const char* cB = (const char*)g.Bt + (size_t)cur.pn * tstep;
    S.a_ready(cur);
    if constexpr (SP2) {
        PG8_STAGE(PG8_SB(0, 0), cB, voffB); PG8_STAGE(PG8_SB(0, 1), cB + hstep, voffB); PG8_STAGE(PG8_SA(0, 0), cA, voffA); PG8_STAGE(PG8_SA(0, 1), cA + hstep, voffA);
        if (wr == 1) PG8_BAR;
        PG8_WAIT_V(2); PG8_BAR;
        PG8_STAGE(PG8_SB(1, 0), cB + kstep, voffB); PG8_STAGE(PG8_SA(1, 0), cA + kstep, voffA); PG8_STAGE(PG8_SB(1, 1), cB + hstep + kstep, voffB);
        PG8_WAIT_V(6); PG8_BAR;
    } else {
        PG8_STAGE(PG8_SB(0, 0), cB, voffB); PG8_STAGE(PG8_SA(0, 0), cA, voffA); PG8_STAGE(PG8_SB(0, 1), cB + hstep, voffB); PG8_STAGE(PG8_SA(0, 1), cA + hstep, voffA);
        if (wr == 1) PG8_BAR;
        PG8_WAIT_V(4); PG8_BAR;
        PG8_STAGE(PG8_SB(1, 0), cB + kstep, voffB); PG8_STAGE(PG8_SA(1, 0), cA + kstep, voffA); PG8_STAGE(PG8_SB(1, 1), cB + hstep + kstep, voffB);
        PG8_WAIT_V(6); PG8_BAR;
    }
    for (;;) {
        const bool has_next = S.next(ui + 1, nxt);
        const char* nA = has_next ? (const char*)g.A + (size_t)nxt.pm * tstep : cA; const char* nB = has_next ? (const char*)g.Bt + (size_t)nxt.pn * tstep : cB;
        for (int t = 0; t < nt; t += 2) {
            const bool last = (t == nt - 2);
            const char* a1 = cA + (size_t)(t + 1) * kstep;
            const char* a2 = last ? nA : cA + (size_t)(t + 2) * kstep; const char* b2 = last ? nB : cB + (size_t)(t + 2) * kstep;
            const char* a3 = a2 + kstep; const char* b3 = b2 + kstep;
            if (last && has_next) S.a_ready(nxt);
            if constexpr (SP2) {
            PG8_LDB(B0, 0, 0); PG8_LDB(B1, 0, 1); PG8_SCHED; PG8_LDA(At, 0, 0); PG8_STAGE(PG8_SA(1, 1), a1 + hstep, voffA);
            PG8_WAIT_V(8); PG8_WAIT_L(0); PG8_BAR; PG8_MMA(0, 0, At, B0); PG8_MMA(0, 1, At, B1); PG8_BAR; PG8_SCHED;
            PG8_LDA(At, 0, 1); PG8_STAGE(PG8_SB(0, 0), b2, voffB); PG8_STAGE(PG8_SB(0, 1), b2 + hstep, voffB); PG8_STAGE(PG8_SA(0, 0), a2, voffA);
            PG8_WAIT_V(8); PG8_WAIT_L(0); PG8_BAR; PG8_MMA(1, 0, At, B0); PG8_MMA(1, 1, At, B1); PG8_BAR; PG8_SCHED;
            PG8_LDB(B0, 1, 0); PG8_LDB(B1, 1, 1); PG8_SCHED; PG8_LDA(At, 1, 0); PG8_STAGE(PG8_SA(0, 1), a2 + hstep, voffA);
            PG8_WAIT_V(8); PG8_WAIT_L(0); PG8_BAR; PG8_MMA(0, 0, At, B0); PG8_MMA(0, 1, At, B1); PG8_BAR; PG8_SCHED;
            PG8_LDA(At, 1, 1); PG8_STAGE(PG8_SB(1, 0), b3, voffB); PG8_STAGE(PG8_SB(1, 1), b3 + hstep, voffB); PG8_STAGE(PG8_SA(1, 0), a3, voffA);
            PG8_WAIT_V(8); PG8_WAIT_L(0); PG8_BAR; PG8_MMA(1, 0, At, B0); PG8_MMA(1, 1, At, B1); PG8_BAR; PG8_SCHED;
            } else {
            PG8_LDB(B0, 0, 0); PG8_SCHED; PG8_LDA(At, 0, 0); PG8_STAGE(PG8_SA(1, 1), a1 + hstep, voffA);
            PG8_WAIT_L(8); PG8_BAR; PG8_WAIT_L(0); PG8_MMA(0, 0, At, B0); PG8_BAR; PG8_SCHED;
            PG8_LDB(B1, 0, 1); PG8_STAGE(PG8_SB(0, 0), b2, voffB);
            PG8_BAR; PG8_WAIT_L(0); PG8_MMA(0, 1, At, B1); PG8_BAR;
            PG8_LDA(At, 0, 1); PG8_STAGE(PG8_SA(0, 0), a2, voffA);
            PG8_BAR; PG8_WAIT_L(0); PG8_MMA(1, 0, At, B0); PG8_BAR; PG8_SCHED;
            PG8_STAGE(PG8_SB(0, 1), b2 + hstep, voffB);
            PG8_WAIT_V(6); PG8_BAR; PG8_MMA(1, 1, At, B1); PG8_BAR;
            PG8_LDB(B0, 1, 0); PG8_SCHED; PG8_LDA(At, 1, 0); PG8_STAGE(PG8_SA(0, 1), a2 + hstep, voffA);
            PG8_WAIT_L(8); PG8_BAR; PG8_WAIT_L(0); PG8_MMA(0, 0, At, B0); PG8_BAR; PG8_SCHED;
            PG8_LDB(B1, 1, 1); PG8_STAGE(PG8_SB(1, 0), b3, voffB);
            PG8_BAR; PG8_WAIT_L(0); PG8_MMA(0, 1, At, B1); PG8_BAR;
            PG8_LDA(At, 1, 1); PG8_STAGE(PG8_SA(1, 0), a3, voffA);
            PG8_BAR; PG8_WAIT_L(0); PG8_MMA(1, 0, At, B0); PG8_BAR; PG8_SCHED;
            PG8_STAGE(PG8_SB(1, 1), b3 + hstep, voffB);
            PG8_WAIT_V(6); PG8_BAR; PG8_MMA(1, 1, At, B1); PG8_BAR;
            }
        }
        if constexpr (ALIGN_EPI) { if (wr == 0) PG8_BAR; }
        if constexpr (!Epi::AFTER_DRAIN) { E(acc, cur, wr, wc, fr, fq); S.done(cur); }
        if (!has_next) break;
#pragma unroll
        for (int a = 0; a < 2; ++a)
#pragma unroll
            for (int b = 0; b < 2; ++b)
#pragma unroll
                for (int m = 0; m < 4; ++m)
#pragma unroll
                    for (int n = 0; n < 2; ++n) acc[a][b][m][n] = (f32x4){0.f, 0.f, 0.f, 0.f};
        cur = nxt; cA = nA; cB = nB; ++ui;
        if constexpr (ALIGN_EPI) { if (wr == 1) PG8_BAR; }
    }
    PG8_WAIT_V(0);
    if constexpr (!ALIGN_EPI) { if (wr == 0) PG8_BAR; }
    PG8_BAR;
    if constexpr (Epi::AFTER_DRAIN) { E.fused(acc, cur, wr, wc, fr, fq, lds, wid, lane); S.done(cur); }
#undef PG8_SA
#undef PG8_SB
#undef PG8_STAGE
#undef PG8_LDA
#undef PG8_LDB
#undef PG8_MMA
#undef PG8_WAIT_V
#undef PG8_WAIT_L
#undef PG8_BAR
#undef PG8_SCHED
}
}

namespace pg8 {
typedef float f32x2e __attribute__((ext_vector_type(2))); typedef __bf16 bf16x2e __attribute__((ext_vector_type(2)));
__device__ __forceinline__ unsigned pk_bf16(float lo, float hi) { f32x2e v = {lo, hi}; bf16x2e b = __builtin_convertvector(v, bf16x2e); return __builtin_bit_cast(unsigned, b); }
struct EpiBf16S {
    static constexpr bool PERM = true, AFTER_DRAIN = false;
    bf16_t* O; int ldc;
    __device__ __forceinline__ void operator()(const f32x4 (&acc)[2][2][4][2], const Unit& u, int wr, int wc, int fr, int fq) const {
        const int row0 = u.pm * BM + wr * 64 + fr, col0 = u.pn * BM + wc * 32 + 8 * fq;
#pragma unroll
        for (int ai = 0; ai < 2; ++ai)
#pragma unroll
            for (int m = 0; m < 4; ++m) { bf16_t* rowp = O + (size_t)(row0 + ai * HALF + m * 16) * ldc + col0;
#pragma unroll
                for (int bj = 0; bj < 2; ++bj) { const f32x4 v0 = acc[ai][bj][m][0], v1 = acc[ai][bj][m][1];
                    u32x4 w; w.x = pk_bf16(v0[0], v0[1]); w.y = pk_bf16(v0[2], v0[3]); w.z = pk_bf16(v1[0], v1[1]); w.w = pk_bf16(v1[2], v1[3]);
                    *(u32x4*)(rowp + bj * HALF) = w; } }
    }
};
struct EpiResF32 {
    static constexpr bool PERM = false, AFTER_DRAIN = false;
    const float* base; float* out; int ldc;
    __device__ __forceinline__ void operator()(const f32x4 (&acc)[2][2][4][2], const Unit& u, int wr, int wc, int fr, int fq) const {
        const int col0 = u.pn * BM + wc * 32 + 4 * fq;
#pragma unroll
        for (int ai = 0; ai < 2; ++ai)
#pragma unroll
            for (int m = 0; m < 4; ++m) { const int r = u.pm * BM + ai * HALF + wr * 64 + m * 16 + fr; const size_t off = (size_t)r * ldc + col0;
#pragma unroll
                for (int bj = 0; bj < 2; ++bj)
#pragma unroll
                    for (int n = 0; n < 2; ++n) { const f32x4 b = *(const f32x4*)(base + off + bj * HALF + n * 16); *(f32x4*)(out + off + bj * HALF + n * 16) = b + acc[ai][bj][m][n]; } }
    }
};
struct EpiSwiGLU {
    static constexpr bool PERM = true, AFTER_DRAIN = false;
    bf16_t* O; int ldc;
    __device__ __forceinline__ static float act(float g, float u) { return g * u * __builtin_amdgcn_rcpf(1.0f + __builtin_amdgcn_exp2f(-1.4426950408889634f * g)); }
    __device__ __forceinline__ void operator()(const f32x4 (&acc)[2][2][4][2], const Unit& u, int wr, int wc, int fr, int fq) const {
        const int row0 = u.pm * BM + wr * 64 + fr, col0 = u.pn * HALF + wc * 32 + 8 * fq;
#pragma unroll
        for (int ai = 0; ai < 2; ++ai)
#pragma unroll
            for (int m = 0; m < 4; ++m) { bf16_t* rowp = O + (size_t)(row0 + ai * HALF + m * 16) * ldc + col0;
                const f32x4 g0 = acc[ai][0][m][0], g1 = acc[ai][0][m][1], u0 = acc[ai][1][m][0], u1 = acc[ai][1][m][1];
                u32x4 w; w.x = pk_bf16(act(g0[0], u0[0]), act(g0[1], u0[1])); w.y = pk_bf16(act(g0[2], u0[2]), act(g0[3], u0[3]));
                w.z = pk_bf16(act(g1[0], u1[0]), act(g1[1], u1[1])); w.w = pk_bf16(act(g1[2], u1[2]), act(g1[3], u1[3]));
                *(u32x4*)(rowp) = w; }
    }
};
}

#define GAS __attribute__((address_space(1)))
#define LAS __attribute__((address_space(3)))
typedef unsigned short bf16;
typedef unsigned u32x4 __attribute__((ext_vector_type(4)));
typedef unsigned u32x2 __attribute__((ext_vector_type(2)));
typedef float f32x4 __attribute__((ext_vector_type(4)));
typedef short bf16x8 __attribute__((ext_vector_type(8)));
typedef float f32x16 __attribute__((ext_vector_type(16)));
constexpr int SEQ = 8192, DM = 4096, DIN = 7488, ZLD = 7680, DFF = 11008;
constexpr int C_CKV = 768, C_KPE = 1280, C_DQ = 1344, C_DK = 3392, C_DV = 5440;
constexpr float EPS = 1e-6f, LOG2E = 1.4426950408889634f;
constexpr float QSC_MLA = 0.07216878364870323f * LOG2E;
constexpr float QSC_DIFF = 0.08838834764831845f * LOG2E;
constexpr float LAMBDA_INIT = 0.2f;
constexpr int NWAVES = 8;
constexpr int LDS_BYTES = 147456;

constexpr size_t WS_BAR = 0;
constexpr size_t WS_WIN = 16384;
constexpr size_t WS_WUQ = WS_WIN + (size_t)ZLD * DM * 2;
constexpr size_t WS_WUKV = WS_WUQ + (size_t)3072 * 768 * 2;
constexpr size_t WS_WO = WS_WUKV + (size_t)4096 * 512 * 2;
constexpr size_t WS_WGU = WS_WO + (size_t)DM * DM * 2;
constexpr size_t WS_WDN = WS_WGU + (size_t)2 * DFF * DM * 2;
constexpr size_t WS_XN = WS_WDN + (size_t)DM * DFF * 2;
constexpr size_t WS_R1 = WS_XN + (size_t)SEQ * DM * 2;
constexpr size_t WS_Z = WS_R1;
constexpr size_t WS_CQN = WS_Z + (size_t)SEQ * ZLD * 2;
constexpr size_t WS_CKVN = WS_CQN + (size_t)SEQ * 768 * 2;
constexpr size_t WS_QRAW = WS_CKVN + (size_t)SEQ * 512 * 2;
constexpr size_t WS_KVRAW = WS_QRAW + (size_t)SEQ * 3072 * 2;
constexpr size_t WS_R1END = WS_KVRAW + (size_t)SEQ * 4096 * 2;
constexpr size_t WS_QA = WS_R1;
constexpr size_t WS_KA = WS_QA + (size_t)SEQ * 3072 * 2;
constexpr size_t WS_VAT = WS_KA + (size_t)SEQ * 3072 * 2;
static_assert(WS_VAT + (size_t)SEQ * 2048 * 2 <= WS_QRAW, "QA|KA|VAT overlay z|cqn|ckvn only");
constexpr size_t WS_OC = WS_QRAW;
constexpr size_t WS_ACT = WS_R1;
static_assert(WS_ACT + (size_t)SEQ * DFF * 2 <= WS_R1END, "act inside R1");
constexpr size_t WS_QD = WS_R1END;
constexpr size_t WS_KD = WS_QD + (size_t)SEQ * 2048 * 2;
constexpr size_t WS_VDT = WS_KD + (size_t)SEQ * 2048 * 2;
constexpr size_t WS_KPE = WS_VDT + (size_t)SEQ * 2048 * 2;
constexpr size_t WS_END = WS_KPE + (size_t)SEQ * 64 * 2;

struct Args { const float* in[21]; float* out; unsigned char* ws; float invf[64]; int ph_lo, ph_hi; };
static_assert(sizeof(Args) == 21 * 8 + 8 + 8 + 256 + 8, "Args has no padding");

__device__ __forceinline__ float wave_sum(float v) {
#pragma unroll
    for (int o = 1; o < 64; o <<= 1) v += __shfl_xor(v, o);
    return v;
}
__device__ __forceinline__ float bflo(unsigned w) { return __uint_as_float(w << 16); }
__device__ __forceinline__ float bfhi(unsigned w) { return __uint_as_float(w & 0xffff0000u); }
__device__ __forceinline__ void unpack8(const u32x4 a, float (&v)[8]) {
    v[0] = bflo(a.x); v[1] = bfhi(a.x); v[2] = bflo(a.y); v[3] = bfhi(a.y); v[4] = bflo(a.z); v[5] = bfhi(a.z); v[6] = bflo(a.w); v[7] = bfhi(a.w);
}
__device__ __forceinline__ u32x4 pack8(const float (&v)[8]) {
    u32x4 w; w.x = pg8::pk_bf16(v[0], v[1]); w.y = pg8::pk_bf16(v[2], v[3]); w.z = pg8::pk_bf16(v[4], v[5]); w.w = pg8::pk_bf16(v[6], v[7]); return w;
}
__device__ __forceinline__ u32x4 ld16(const bf16* p) { return *(const u32x4*)p; }
__device__ __forceinline__ void st16(bf16* p, u32x4 v) { *(u32x4*)p = v; }
__device__ __forceinline__ void ldg8(const float* g, float (&v)[8]) { const f32x4 a = *(const f32x4*)g, b = *(const f32x4*)(g + 4); v[0] = a.x; v[1] = a.y; v[2] = a.z; v[3] = a.w; v[4] = b.x; v[5] = b.y; v[6] = b.z; v[7] = b.w; }
__device__ __forceinline__ void rope_cs(int pos, float invf, float& c, float& s) {
    const float ang = (float)pos * invf; const double rev = (double)ang * 0.15915494309189535; const float fr = (float)(rev - __builtin_rint(rev));
    c = __builtin_amdgcn_cosf(fr); s = __builtin_amdgcn_sinf(fr);
}

__device__ __forceinline__ void p0_transpose_item(const float* W, int K, int N, bf16* WT, int mode, LAS float* scr, int item, int lane) {
    const int nblk = N / 32, kb = item / nblk, nb = item % nblk, k0 = 64 * kb, n0 = 32 * nb;
    {
        f32x4 t[8]; const int kq = lane >> 3, n4 = (lane & 7) * 4;
#pragma unroll
        for (int i = 0; i < 8; ++i) t[i] = *(const f32x4*)(W + (size_t)(k0 + kq + 8 * i) * N + n0 + n4);
#pragma unroll
        for (int i = 0; i < 8; ++i) { LAS float* d = scr + (kq + 8 * i) * 33 + n4; d[0] = t[i].x; d[1] = t[i].y; d[2] = t[i].z; d[3] = t[i].w; }
    }
    asm volatile("s_waitcnt lgkmcnt(0)" ::: "memory");
    const int c = lane & 7;
    const int rbase = (mode == 0) ? n0 : (((n0 >> 7) << 8) + (n0 & 127) + (mode == 2 ? 128 : 0));
#pragma unroll
    for (int j = 0; j < 4; ++j) { const int n = (lane >> 3) + 8 * j; const LAS float* s = scr + (8 * c) * 33 + n;
        u32x4 o; o.x = pg8::pk_bf16(s[0 * 33], s[1 * 33]); o.y = pg8::pk_bf16(s[2 * 33], s[3 * 33]); o.z = pg8::pk_bf16(s[4 * 33], s[5 * 33]); o.w = pg8::pk_bf16(s[6 * 33], s[7 * 33]);
        *(u32x4*)(WT + (size_t)(rbase + n) * K + k0 + 8 * c) = o; }
    asm volatile("s_waitcnt lgkmcnt(0)" ::: "memory");
}
struct ItemRegs { f32x4 t[8]; };
__device__ __forceinline__ void item_load(ItemRegs& R, const float* W, int N, int item, int lane) {
    const int nblk = N / 32, kb = item / nblk, nb = item % nblk, k0 = 64 * kb, n0 = 32 * nb, kq = lane >> 3, n4 = (lane & 7) * 4;
#pragma unroll
    for (int i = 0; i < 8; ++i) R.t[i] = *(const f32x4*)(W + (size_t)(k0 + kq + 8 * i) * N + n0 + n4);
}
__device__ __forceinline__ void item_store(const ItemRegs& R, int K, int N, bf16* WT, int mode, LAS float* scr, int item, int lane) {
    const int nblk = N / 32, kb = item / nblk, nb = item % nblk, k0 = 64 * kb, n0 = 32 * nb, kq = lane >> 3, n4 = (lane & 7) * 4;
#pragma unroll
    for (int i = 0; i < 8; ++i) { LAS float* d = scr + (kq + 8 * i) * 33 + n4; d[0] = R.t[i].x; d[1] = R.t[i].y; d[2] = R.t[i].z; d[3] = R.t[i].w; }
    asm volatile("s_waitcnt lgkmcnt(0)" ::: "memory");
    const int c = lane & 7;
    const int rbase = (mode == 0) ? n0 : (((n0 >> 7) << 8) + (n0 & 127) + (mode == 2 ? 128 : 0));
#pragma unroll
    for (int j = 0; j < 4; ++j) { const int n = (lane >> 3) + 8 * j; const LAS float* s = scr + (8 * c) * 33 + n;
        u32x4 o; o.x = pg8::pk_bf16(s[0 * 33], s[1 * 33]); o.y = pg8::pk_bf16(s[2 * 33], s[3 * 33]); o.z = pg8::pk_bf16(s[4 * 33], s[5 * 33]); o.w = pg8::pk_bf16(s[6 * 33], s[7 * 33]);
        *(u32x4*)(WT + (size_t)(rbase + n) * K + k0 + 8 * c) = o; }
    asm volatile("s_waitcnt lgkmcnt(0)" ::: "memory");
}
__device__ __forceinline__ void conv_stream(const float* W, int K, int N, bf16* WT, int mode, LAS float* scr, int begin, int end, int stride, int lane) {
    if (begin >= end) return;
    ItemRegs r0, r1, r2; item_load(r0, W, N, begin, lane); if (begin + stride < end) item_load(r1, W, N, begin + stride, lane);
    for (int it = begin; it < end; it += stride) { const int it2 = it + 2 * stride; if (it2 < end) item_load(r2, W, N, it2, lane); item_store(r0, K, N, WT, mode, scr, it, lane); r0 = r1; r1 = r2; }
}
__device__ __forceinline__ void rms_row_4096(const float* xrow, const float* g, bf16* orow, int lane) {
    const f32x4* xr = (const f32x4*)xrow + lane; f32x4 v[16]; float s = 0.f;
#pragma unroll
    for (int j = 0; j < 16; ++j) { v[j] = xr[64 * j]; s += (v[j].x * v[j].x + v[j].y * v[j].y) + (v[j].z * v[j].z + v[j].w * v[j].w); }
    const float rstd = 1.0f / sqrtf(wave_sum(s) * (1.f / 4096.f) + EPS);
    const f32x4* gr = (const f32x4*)g + lane; u32x2* o8 = (u32x2*)orow + lane;
#pragma unroll
    for (int j = 0; j < 16; ++j) { const f32x4 gg = gr[64 * j]; u32x2 w; w.x = pg8::pk_bf16(v[j].x * rstd * gg.x, v[j].y * rstd * gg.y); w.y = pg8::pk_bf16(v[j].z * rstd * gg.z, v[j].w * rstd * gg.w); o8[64 * j] = w; }
}
#define RLX_AGENT __ATOMIC_RELAXED, __HIP_MEMORY_SCOPE_AGENT
#define XB_TMO      128
#define XB_XCNT(j)  (256  + 64 * (j))
#define XB_XSUB(j)  (1280 + 64 * (j))
#define XB_XGEN(j)  (2304 + 64 * (j))
#define XB_TOP      3328
#define XB_TOPGEN   3392
#define XCD_BAR_WORDS 3456
#define XB_SPIN_CAP (1u << 18)

__device__ __forceinline__ unsigned xb_ld(unsigned* p)              { return __hip_atomic_load(p, __ATOMIC_RELAXED, __HIP_MEMORY_SCOPE_AGENT); }
__device__ __forceinline__ unsigned xb_add(unsigned* p, unsigned v) { return __hip_atomic_fetch_add(p, v, __ATOMIC_RELAXED, __HIP_MEMORY_SCOPE_AGENT); }
__device__ __forceinline__ unsigned xb_xcc_id() { return (unsigned)__builtin_amdgcn_s_getreg((3 << 11) | 20) & 0xFu; }
#define XB_SPIN(cond, bar) do { unsigned _sp = 0; while (cond) { __builtin_amdgcn_s_sleep(1); \
    if ((++_sp & 255u) == 0u) { if (xb_ld(&(bar)[XB_TMO])) break; if (_sp > XB_SPIN_CAP) { atomicAdd(&(bar)[XB_TMO], 1u); break; } } } } while (0)

struct XcdBarrier {
    unsigned* bar; unsigned x;
    volatile LAS unsigned* st;
};

__device__ __forceinline__ XcdBarrier xcd_barrier_post(unsigned* bar, volatile LAS unsigned* st, bool t0) {
    XcdBarrier b; b.bar = bar; b.x = xb_xcc_id(); b.st = st;
    if (t0) (void)xb_add(&bar[XB_XCNT(b.x)], 1u);
    return b;
}
__device__ __forceinline__ void xcd_barrier_complete(unsigned* bar, unsigned x, unsigned& nloc, unsigned& nx) {
    const unsigned G = gridDim.x * gridDim.y * gridDim.z;
    unsigned sum, cnt, mine, sp = 0u;
    for (;;) {
        sum = 0u; cnt = 0u; mine = 0u;
#pragma unroll
        for (unsigned j = 0; j < 16; ++j) { const unsigned c = xb_ld(&bar[XB_XCNT(j)]); sum += c; cnt += (c > 0u) ? 1u : 0u; mine = (j == x) ? c : mine; }
        if (sum == G) break;
        __builtin_amdgcn_s_sleep(1);
        if ((++sp & 255u) == 0u) { if (xb_ld(&bar[XB_TMO])) break; if (sp > XB_SPIN_CAP) { atomicAdd(&bar[XB_TMO], 1u); break; } }
    }
    nloc = mine > 0u ? mine : 1u; nx = cnt > 0u ? cnt : 1u;
}

__device__ __forceinline__ void xcd_barrier(const XcdBarrier& b, bool t0) {
    asm volatile("s_waitcnt vmcnt(0)" ::: "memory");
    __syncthreads();
    if (t0) {
        unsigned* bar = b.bar;
        __builtin_amdgcn_s_waitcnt(0);
        unsigned nloc = b.st[0], nx = b.st[1];
        if (nloc == 0u) { xcd_barrier_complete(bar, b.x, nloc, nx); b.st[0] = nloc; b.st[1] = nx; }
        const unsigned old = xb_add(&bar[XB_XSUB(b.x)], 1u);
        const unsigned gen = old / nloc;
        if (old + 1u == (gen + 1u) * nloc) {
            __builtin_amdgcn_fence(__ATOMIC_RELEASE, "agent");
            asm volatile("s_waitcnt vmcnt(0)" ::: "memory");
            const unsigned og = xb_add(&bar[XB_TOP], 1u);
            const unsigned tg = og / nx;
            if (og + 1u == (tg + 1u) * nx) xb_add(&bar[XB_TOPGEN], 1u);
            else XB_SPIN(xb_ld(&bar[XB_TOPGEN]) == tg, bar);
            __builtin_amdgcn_fence(__ATOMIC_ACQUIRE, "agent");
            xb_add(&bar[XB_XGEN(b.x)], 1u);
            asm volatile("s_waitcnt vmcnt(0)" ::: "memory");
        } else {
            XB_SPIN(xb_ld(&bar[XB_XGEN(b.x)]) == gen, bar);
            __builtin_amdgcn_fence(__ATOMIC_ACQUIRE, "agent");
            asm volatile("s_waitcnt vmcnt(0)" ::: "memory");
        }
    }
    __syncthreads();
}

constexpr int TP_PITCH = 1040;
__device__ __forceinline__ void tp_store(LAS const unsigned char* tl, bf16* dst, int s0, int tid) {
#pragma unroll
    for (int k = 0; k < 4; ++k) { const int idx = tid + 512 * k, sg = idx & 3, col = idx >> 2; const LAS unsigned char* p = tl + (8 * sg) * TP_PITCH + 2 * col;
        unsigned short e[8];
#pragma unroll
        for (int i = 0; i < 8; ++i) e[i] = *(const LAS unsigned short*)(p + i * TP_PITCH);
        u32x4 w; w.x = e[0] | ((unsigned)e[1] << 16); w.y = e[2] | ((unsigned)e[3] << 16); w.z = e[4] | ((unsigned)e[5] << 16); w.w = e[6] | ((unsigned)e[7] << 16);
        st16(dst + (size_t)col * SEQ + s0 + 8 * sg, w); }
}

struct P2Row { u32x4 cq0, cq1, ckv, kpe, dq[4], dk[4]; };
__device__ __forceinline__ void p2_load(P2Row& R, const bf16* zr, int lane) {
    const u32x4 z4 = {0u, 0u, 0u, 0u}; const int sub = lane & 15;
    R.cq0 = ld16(zr + 8 * lane); R.cq1 = (lane < 32) ? ld16(zr + 512 + 8 * lane) : z4; R.ckv = ld16(zr + C_CKV + 8 * lane); R.kpe = (lane < 8) ? ld16(zr + C_KPE + 8 * lane) : z4;
#pragma unroll
    for (int rd = 0; rd < 4; ++rd) { const int head = rd * 4 + (lane >> 4); R.dq[rd] = ld16(zr + C_DQ + head * 128 + sub * 8); R.dk[rd] = ld16(zr + C_DK + head * 128 + sub * 8); }
}
__device__ __forceinline__ void p2_phase(const Args& A, LAS unsigned char* lds, int vcu, int G, int tid, int wave, int lane) {
    unsigned char* ws = A.ws;
    const bf16* Z = (const bf16*)(ws + WS_Z); bf16* CQN = (bf16*)(ws + WS_CQN); bf16* CKVN = (bf16*)(ws + WS_CKVN); bf16* KPE = (bf16*)(ws + WS_KPE);
    bf16* QD = (bf16*)(ws + WS_QD); bf16* KD = (bf16*)(ws + WS_KD); bf16* VDT = (bf16*)(ws + WS_VDT);
    const int sub = lane & 15;
    float gq0[8], gq1[8], gkv[8], gdq[8], gdk[8];
    ldg8(A.in[3] + 8 * lane, gq0); ldg8(A.in[3] + 512 + 8 * (lane & 31), gq1); ldg8(A.in[4] + 8 * lane, gkv); ldg8(A.in[9] + 8 * sub, gdq); ldg8(A.in[10] + 8 * sub, gdk);
    float ifr[8];
#pragma unroll
    for (int e = 0; e < 8; ++e) ifr[e] = A.invf[8 * (sub & 7) + e];
    for (int unit = vcu; unit < SEQ / 32; unit += G) {
        const int s0 = unit * 32;
        P2Row cur, nxt;
        p2_load(cur, Z + (size_t)(s0 + wave * 4) * ZLD, lane);
#pragma unroll
        for (int i = 0; i < 4; ++i) {
            const int row = s0 + wave * 4 + i;
            if (i < 3) p2_load(nxt, Z + (size_t)(row + 1) * ZLD, lane);
            {
                float va[8], vb[8]; unpack8(cur.cq0, va); unpack8(cur.cq1, vb); float ss = 0.f;
#pragma unroll
                for (int e = 0; e < 8; ++e) ss += va[e] * va[e] + vb[e] * vb[e];
                const float rstd = 1.0f / sqrtf(wave_sum(ss) * (1.f / 768.f) + EPS);
#pragma unroll
                for (int e = 0; e < 8; ++e) { va[e] = va[e] * rstd * gq0[e]; vb[e] = vb[e] * rstd * gq1[e]; }
                st16(CQN + (size_t)row * 768 + 8 * lane, pack8(va));
                if (lane < 32) st16(CQN + (size_t)row * 768 + 512 + 8 * lane, pack8(vb));
            }
            {
                float va[8]; unpack8(cur.ckv, va); float ss = 0.f;
#pragma unroll
                for (int e = 0; e < 8; ++e) ss += va[e] * va[e];
                const float rstd = 1.0f / sqrtf(wave_sum(ss) * (1.f / 512.f) + EPS);
#pragma unroll
                for (int e = 0; e < 8; ++e) va[e] = va[e] * rstd * gkv[e];
                st16(CKVN + (size_t)row * 512 + 8 * lane, pack8(va));
            }
            if (lane < 8) st16(KPE + (size_t)row * 64 + 8 * lane, cur.kpe);
            float cs[8], sn[8];
#pragma unroll
            for (int e = 0; e < 8; ++e) rope_cs(row, ifr[e], cs[e], sn[e]);
#pragma unroll
            for (int which = 0; which < 2; ++which) {
                bf16* dst = which ? KD : QD; const float osc = which ? 1.0f : QSC_DIFF;
#pragma unroll
                for (int rd = 0; rd < 4; ++rd) {
                    const int head = rd * 4 + (lane >> 4);
                    float v[8]; unpack8(which ? cur.dk[rd] : cur.dq[rd], v); float ss = 0.f;
#pragma unroll
                    for (int e = 0; e < 8; ++e) ss += v[e] * v[e];
                    ss += __shfl_xor(ss, 1); ss += __shfl_xor(ss, 2); ss += __shfl_xor(ss, 4); ss += __shfl_xor(ss, 8);
                    const float rstd = 1.0f / sqrtf(ss * (1.f / 128.f) + EPS);
                    float o[8];
#pragma unroll
                    for (int e = 0; e < 8; ++e) { const float y = v[e] * rstd * (which ? gdk[e] : gdq[e]); const float p = __shfl_xor(y, 8); o[e] = ((sub < 8) ? (y * cs[e] - p * sn[e]) : (y * cs[e] + p * sn[e])) * osc; }
                    st16(dst + (size_t)row * 2048 + head * 128 + sub * 8, pack8(o));
                }
            }
            cur = nxt;
        }
        for (int pass = 0; pass < 4; ++pass) {
            __syncthreads();
#pragma unroll
            for (int k = 0; k < 4; ++k) { const int idx = tid + 512 * k, r = idx >> 6, c = idx & 63;
                *(LAS u32x4*)(lds + r * TP_PITCH + 16 * c) = ld16(Z + (size_t)(s0 + r) * ZLD + C_DV + 512 * pass + 8 * c); }
            __syncthreads();
            tp_store(lds, VDT + (size_t)(512 * pass) * SEQ, s0, tid);
        }
        __syncthreads();
    }
}

struct P4Row { u32x4 q[8], k[8]; };
__device__ __forceinline__ void p4_load(P4Row& R, const bf16* QRAW, const bf16* KVRAW, const bf16* KPE, int row, int lane) {
    const u32x4 z4 = {0u, 0u, 0u, 0u}; const int sub = lane & 31, hsel = lane >> 5; const bool act = sub < 24;
    const u32x4 kpe = (sub >= 16 && act) ? ld16(KPE + (size_t)row * 64 + (sub - 16) * 8) : z4;
#pragma unroll
    for (int rd = 0; rd < 8; ++rd) { const int head = 2 * rd + hsel;
        R.q[rd] = act ? ld16(QRAW + (size_t)row * 3072 + head * 192 + sub * 8) : z4;
        R.k[rd] = (sub < 16) ? ld16(KVRAW + (size_t)row * 4096 + head * 256 + sub * 8) : kpe; }
}
__device__ __forceinline__ void p4_phase(const Args& A, LAS unsigned char* lds, int vcu, int G, int tid, int wave, int lane) {
    unsigned char* ws = A.ws;
    const bf16* QRAW = (const bf16*)(ws + WS_QRAW); const bf16* KVRAW = (const bf16*)(ws + WS_KVRAW); const bf16* KPE = (const bf16*)(ws + WS_KPE);
    bf16* QA = (bf16*)(ws + WS_QA); bf16* KA = (bf16*)(ws + WS_KA); bf16* VAT = (bf16*)(ws + WS_VAT);
    const int sub = lane & 31, hsel = lane >> 5; const bool act = sub < 24; const int subc = act ? sub : 0;
    const bool rlo = (sub >= 16 && sub < 20), rhi = (sub >= 20 && sub < 24);
    float gq[8], gk[8]; ldg8(A.in[7] + 8 * subc, gq); ldg8(A.in[8] + 8 * subc, gk);
    float ifr[8];
#pragma unroll
    for (int e = 0; e < 8; ++e) ifr[e] = A.invf[2 * (8 * (sub & 3) + e)];
    for (int unit = vcu; unit < SEQ / 32; unit += G) {
        const int s0 = unit * 32;
        for (int i = 0; i < 4; ++i) {
            const int row = s0 + wave * 4 + i;
            P4Row cur; { int lo_ = lane; asm volatile("" : "+v"(lo_)); p4_load(cur, QRAW, KVRAW, KPE, row, lo_); }
            float cs[8], sn[8];
#pragma unroll
            for (int e = 0; e < 8; ++e) rope_cs(row, ifr[e], cs[e], sn[e]);
#pragma unroll
            for (int which = 0; which < 2; ++which) {
                bf16* dst = which ? KA : QA; const float osc = which ? 1.0f : QSC_MLA;
#pragma unroll
                for (int rd = 0; rd < 8; ++rd) {
                    const int head = 2 * rd + hsel;
                    float v[8]; unpack8(which ? cur.k[rd] : cur.q[rd], v); float ss = 0.f;
#pragma unroll
                    for (int e = 0; e < 8; ++e) ss += v[e] * v[e];
                    ss += __shfl_xor(ss, 1); ss += __shfl_xor(ss, 2); ss += __shfl_xor(ss, 4); ss += __shfl_xor(ss, 8); ss += __shfl_xor(ss, 16);
                    const float rstd = 1.0f / sqrtf(ss * (1.f / 192.f) + EPS);
                    float o[8];
#pragma unroll
                    for (int e = 0; e < 8; ++e) { const float y = v[e] * rstd * (which ? gk[e] : gq[e]); const float p = __shfl_xor(y, 4);
                        float r = y; if (rlo) r = y * cs[e] - p * sn[e]; if (rhi) r = y * cs[e] + p * sn[e]; o[e] = r * osc; }
                    if (act) st16(dst + (size_t)row * 3072 + head * 192 + sub * 8, pack8(o));
                }
            }
        }
        for (int pass = 0; pass < 4; ++pass) {
            __syncthreads();
#pragma unroll
            for (int k = 0; k < 4; ++k) { const int idx = tid + 512 * k, r = idx >> 6, c = idx & 63, hl = c >> 4, cc = c & 15;
                *(LAS u32x4*)(lds + r * TP_PITCH + 16 * c) = ld16(KVRAW + (size_t)(s0 + r) * 4096 + (4 * pass + hl) * 256 + 128 + 8 * cc); }
            __syncthreads();
            tp_store(lds, VAT + (size_t)(512 * pass) * SEQ, s0, tid);
        }
        __syncthreads();
    }
}

namespace att {
__device__ __forceinline__ int swap23(int i) { return (i & ~12) | ((i & 4) << 1) | ((i & 8) >> 1); }
__device__ __forceinline__ void glds16(const void* gsrc, unsigned lds_dst) { unsigned keep;
    asm volatile("s_mov_b32 %0, m0\n\ts_mov_b32 m0, %2\n\ts_nop 0\n\tglobal_load_lds_dwordx4 %1, off\n\ts_mov_b32 m0, %0" : "=&s"(keep) : "v"(gsrc), "s"(lds_dst) : "memory"); }
#define ATT_WAIT_BAR() asm volatile("s_waitcnt vmcnt(0) lgkmcnt(0)\n\ts_barrier" ::: "memory")
__device__ __forceinline__ int crow(int r, int hi) { return (r & 3) + 8 * (r >> 2) + 4 * hi; }

#define ATT_SB() do { asm volatile("" ::: "memory"); __builtin_amdgcn_sched_barrier(0); } while (0)
template <int ND_A, int ND_B>
__device__ __forceinline__ bf16x8 frag_load(const LAS unsigned char* kA, const LAS unsigned char* kB, const LAS unsigned char* vt, int e, int kb, int r32, int xk, int xv) {
    constexpr int ND = ND_A + ND_B;
    if (e < ND_A) return *(const LAS bf16x8*)(kA + (32 * kb + r32) * 256 + (((2 * e) ^ xk) << 4));
    if (e < ND) return *(const LAS bf16x8*)(kB + (32 * kb + r32) * 128 + (((2 * (e - ND_A)) ^ xv) << 4));
    const int db = (e - ND) >> 1, ss = (e - ND) & 1;
    return *(const LAS bf16x8*)(vt + (32 * db + r32) * 128 + (((4 * kb + 2 * ss) ^ xv) << 4));
}
template <int ND_A, int ND_B, int NDB, int PD>
__device__ __forceinline__ void tile_compute(const bf16x8 (&fpre)[PD], const LAS unsigned char* kA, const LAS unsigned char* kB, const LAS unsigned char* vt, const bf16x8* qf, f32x16* o, float& lsum, int r32, int hi) {
    constexpr int ND = ND_A + ND_B, TOT = ND + 2 * NDB;
    bf16x8 f[2][TOT + PD];
#pragma unroll
    for (int i = 0; i < PD; ++i) f[0][i] = fpre[i];
    const int r32in = r32;
#pragma unroll
    for (int kb = 0; kb < 2; ++kb) {
        int r32 = r32in; asm volatile("" : "+v"(r32));
        const int xk = (r32 & 15) ^ hi, xv = ((r32 >> 1) & 7) ^ hi;
        f32x16 s = {0.f, 0.f, 0.f, 0.f, 0.f, 0.f, 0.f, 0.f, 0.f, 0.f, 0.f, 0.f, 0.f, 0.f, 0.f, 0.f};
#pragma unroll
        for (int e = 0; e < ND; ++e) {
            f[kb][e + PD] = frag_load<ND_A, ND_B>(kA, kB, vt, e + PD, kb, r32, xk, xv);
            s = __builtin_amdgcn_mfma_f32_32x32x16_bf16(f[kb][e], qf[e], s, 0, 0, 0);
            ATT_SB();
        }
        float la = 0.f, lb = 0.f; u32x4 w0, w1;
        { const float p0 = __builtin_amdgcn_exp2f(s[0]), p1 = __builtin_amdgcn_exp2f(s[1]), p2 = __builtin_amdgcn_exp2f(s[2]), p3 = __builtin_amdgcn_exp2f(s[3]); la += p0 + p2; lb += p1 + p3; w0.x = pg8::pk_bf16(p0, p1); w0.y = pg8::pk_bf16(p2, p3); }
        { const float p0 = __builtin_amdgcn_exp2f(s[4]), p1 = __builtin_amdgcn_exp2f(s[5]), p2 = __builtin_amdgcn_exp2f(s[6]), p3 = __builtin_amdgcn_exp2f(s[7]); la += p0 + p2; lb += p1 + p3; w0.z = pg8::pk_bf16(p0, p1); w0.w = pg8::pk_bf16(p2, p3); }
        { const float p0 = __builtin_amdgcn_exp2f(s[8]), p1 = __builtin_amdgcn_exp2f(s[9]), p2 = __builtin_amdgcn_exp2f(s[10]), p3 = __builtin_amdgcn_exp2f(s[11]); la += p0 + p2; lb += p1 + p3; w1.x = pg8::pk_bf16(p0, p1); w1.y = pg8::pk_bf16(p2, p3); }
        { const float p0 = __builtin_amdgcn_exp2f(s[12]), p1 = __builtin_amdgcn_exp2f(s[13]), p2 = __builtin_amdgcn_exp2f(s[14]), p3 = __builtin_amdgcn_exp2f(s[15]); la += p0 + p2; lb += p1 + p3; w1.z = pg8::pk_bf16(p0, p1); w1.w = pg8::pk_bf16(p2, p3); }
        lsum += la + lb;
        const bf16x8 pb0 = __builtin_bit_cast(bf16x8, w0), pb1 = __builtin_bit_cast(bf16x8, w1);
        ATT_SB();
#pragma unroll
        for (int e = ND; e < TOT; ++e) {
            if (e + PD < TOT) f[kb][e + PD] = frag_load<ND_A, ND_B>(kA, kB, vt, e + PD, kb, r32, xk, xv);
            else if (kb == 0) f[1][e + PD - TOT] = frag_load<ND_A, ND_B>(kA, kB, vt, e + PD - TOT, 1, r32, xk, xv);
            const int db = (e - ND) >> 1;
            o[db] = __builtin_amdgcn_mfma_f32_32x32x16_bf16(f[kb][e], ((e - ND) & 1) ? pb1 : pb0, o[db], 0, 0, 0);
            ATT_SB();
        }
    }
}

template <int ND_A, int ND_B, int NDB>
__device__ __forceinline__ void tile_compute_simple(const LAS unsigned char* kA, const LAS unsigned char* kB, const LAS unsigned char* vt, const bf16x8* qf, f32x16* o, float& lsum, int r32, int hi) {
    static_assert(ND_B == 0, "simple form: one K region");
    const int xk = (r32 & 15) ^ hi, xv = ((r32 >> 1) & 7) ^ hi;
#pragma unroll
    for (int kb = 0; kb < 2; ++kb) {
        f32x16 s = {0.f, 0.f, 0.f, 0.f, 0.f, 0.f, 0.f, 0.f, 0.f, 0.f, 0.f, 0.f, 0.f, 0.f, 0.f, 0.f};
        const LAS unsigned char* ka = kA + (32 * kb + r32) * 256;
        bf16x8 a = *(const LAS bf16x8*)(ka + ((0 ^ xk) << 4));
#pragma unroll
        for (int d0 = 0; d0 < ND_A; ++d0) { bf16x8 an = a; if (d0 + 1 < ND_A) an = *(const LAS bf16x8*)(ka + (((2 * (d0 + 1)) ^ xk) << 4));
            s = __builtin_amdgcn_mfma_f32_32x32x16_bf16(a, qf[d0], s, 0, 0, 0); a = an; __builtin_amdgcn_sched_barrier(0); }
        const LAS unsigned char* vr = vt + r32 * 128;
        bf16x8 v0 = *(const LAS bf16x8*)(vr + (((4 * kb) ^ xv) << 4)), v1 = *(const LAS bf16x8*)(vr + (((4 * kb + 2) ^ xv) << 4));
        float p[16];
#pragma unroll
        for (int r = 0; r < 16; ++r) { p[r] = __builtin_amdgcn_exp2f(s[r]); lsum += p[r]; }
        u32x4 w0, w1; w0.x = pg8::pk_bf16(p[0], p[1]); w0.y = pg8::pk_bf16(p[2], p[3]); w0.z = pg8::pk_bf16(p[4], p[5]); w0.w = pg8::pk_bf16(p[6], p[7]);
        w1.x = pg8::pk_bf16(p[8], p[9]); w1.y = pg8::pk_bf16(p[10], p[11]); w1.z = pg8::pk_bf16(p[12], p[13]); w1.w = pg8::pk_bf16(p[14], p[15]);
        const bf16x8 pb0 = __builtin_bit_cast(bf16x8, w0), pb1 = __builtin_bit_cast(bf16x8, w1);
        __builtin_amdgcn_sched_barrier(0);
#pragma unroll
        for (int db = 0; db < NDB; ++db) { bf16x8 n0 = v0, n1 = v1;
            if (db + 1 < NDB) { n0 = *(const LAS bf16x8*)(vr + (db + 1) * 4096 + (((4 * kb) ^ xv) << 4)); n1 = *(const LAS bf16x8*)(vr + (db + 1) * 4096 + (((4 * kb + 2) ^ xv) << 4)); }
            o[db] = __builtin_amdgcn_mfma_f32_32x32x16_bf16(v0, pb0, o[db], 0, 0, 0); o[db] = __builtin_amdgcn_mfma_f32_32x32x16_bf16(v1, pb1, o[db], 0, 0, 0); v0 = n0; v1 = n1; __builtin_amdgcn_sched_barrier(0); }
    }
}

constexpr int MLA_STAGE = 40960, DIFF_STAGE = 65536;
#ifndef DIFF_PD
#define DIFF_PD 0
#endif
__device__ __forceinline__ void glds16s(unsigned voff, const void* sbase, unsigned lds_dst) { unsigned keep;
    asm volatile("s_nop 3\n\ts_mov_b32 %0, m0\n\ts_mov_b32 m0, %3\n\ts_nop 0\n\tglobal_load_lds_dwordx4 %1, %2\n\ts_mov_b32 m0, %0" : "=&s"(keep) : "v"(voff), "s"(sbase), "s"(lds_dst) : "memory"); }
__device__ __forceinline__ void mla_stage(const char* Kb, const char* Vb, int t, unsigned dst, int wave, int lane) {
    asm volatile("" : "+v"(lane));
    const unsigned q = lane >> 4, g3 = lane >> 3;
    const unsigned Bn = ((lane & 15) ^ q) * 16, Br = ((lane & 7) ^ q) * 16;
    const int w0 = wave & 1, w1 = (wave >> 1) & 1, w2 = wave >> 2;
    const char* kbase = Kb + (size_t)(64 * t + 32 * w2 + 16 * w1 + 4 * w0) * 6144;
#pragma unroll
    for (int j = 0; j < 2; ++j)
        glds16s(q * 6144 + (Bn ^ (unsigned)(128 * w0 + 64 * j)), kbase + (size_t)(8 * j) * 6144, (unsigned)__builtin_amdgcn_readfirstlane(dst + (2 * wave + j) * 1024));
    glds16s((8 * (lane >> 5) + (g3 & 3)) * 6144 + (Br ^ (unsigned)(64 * w0)), kbase + 256, (unsigned)__builtin_amdgcn_readfirstlane(dst + 16384 + wave * 1024));
    const char* vbase = Vb + (size_t)(2 * wave) * 8 * (SEQ * 2) + t * 128;
#pragma unroll
    for (int j = 0; j < 2; ++j)
        glds16s(g3 * (SEQ * 2) + (Br ^ (unsigned)(64 * j)), vbase + (size_t)j * 8 * (SEQ * 2), (unsigned)__builtin_amdgcn_readfirstlane(dst + 24576 + (2 * wave + j) * 1024));
}
__device__ __forceinline__ void diff_stage(const char* Kb, const char* Vb, int t, unsigned dst, int wave, int lane) {
    asm volatile("" : "+v"(lane));
    const unsigned q = lane >> 4;
    if (wave < 4) {
        const unsigned A = q * 4096, B = ((lane & 15) ^ q) * 16;
        const char* base = Kb + (wave >> 1) * 256 + (size_t)(64 * t + 32 * (wave & 1)) * 4096;
#pragma unroll
        for (int k = 0; k < 8; ++k) { const int Kk = 16 * (k >> 2) + 8 * (k & 1) + 4 * ((k >> 1) & 1);
            glds16s(A + (B ^ (unsigned)(64 * (k & 3))), base + (size_t)Kk * 4096, (unsigned)__builtin_amdgcn_readfirstlane(dst + (wave * 8 + k) * 1024)); }
    } else {
        const unsigned A = (lane >> 3) * (SEQ * 2), B = ((lane & 7) ^ q) * 16;
        const char* base = Vb + (size_t)(wave - 4) * 64 * (SEQ * 2) + t * 128;
#pragma unroll
        for (int k = 0; k < 8; ++k)
            glds16s(A + (B ^ (unsigned)(64 * (k & 1))), base + (size_t)k * 8 * (SEQ * 2), (unsigned)__builtin_amdgcn_readfirstlane(dst + (wave * 8 + k) * 1024));
    }
}

__device__ __forceinline__ void mla_unit(int h, int qb, const bf16* QA, const bf16* KA, const bf16* VAT, bf16* OC, LAS unsigned char* lds, int wave, int lane) {
    const int r32 = lane & 31, hi = lane >> 5; const unsigned lds0 = (unsigned)(uintptr_t)lds;
    const int row = 256 * qb + 32 * wave + r32, cw = 4 * qb + (wave >> 1), NT = 4 * qb + 4;
    const char* Kb = (const char*)(KA + h * 192); const char* Vb = (const char*)(VAT + (size_t)h * 128 * SEQ);
    mla_stage(Kb, Vb, 0, lds0, wave, lane);
    bf16x8 qf[12];
#pragma unroll
    for (int d0 = 0; d0 < 12; ++d0) qf[d0] = *(const bf16x8*)(QA + (size_t)row * 3072 + h * 192 + 16 * d0 + 8 * hi);
#pragma unroll
    for (int d0 = 0; d0 < 12; ++d0) asm volatile("" : "+v"(qf[d0]));
    f32x16 o[4];
#pragma unroll
    for (int db = 0; db < 4; ++db)
#pragma unroll
        for (int r = 0; r < 16; ++r) o[db][r] = 0.f;
    float lsum = 0.f;
    for (int t = 0; t < NT; ++t) {
        ATT_WAIT_BAR();
        const LAS unsigned char* sb = lds + (t & 1) * MLA_STAGE; int r32o = r32; asm volatile("" : "+v"(r32o));
        bf16x8 fp[2];
        if (t <= cw) { fp[0] = frag_load<8, 4>(sb, sb + 16384, sb + 24576, 0, 0, r32o, (r32o & 15) ^ hi, ((r32o >> 1) & 7) ^ hi); fp[1] = frag_load<8, 4>(sb, sb + 16384, sb + 24576, 1, 0, r32o, (r32o & 15) ^ hi, ((r32o >> 1) & 7) ^ hi); }
        if (t + 1 < NT) mla_stage(Kb, Vb, t + 1, lds0 + ((t + 1) & 1) * MLA_STAGE, wave, lane);
        if (t <= cw) tile_compute<8, 4, 4, 2>(fp, sb, sb + 16384, sb + 24576, qf, o, lsum, r32o, hi);
    }
    lsum += __shfl_xor(lsum, 32);
    const float inv = 1.0f / lsum;
    bf16* orow = OC + (size_t)row * 4096 + h * 128;
#pragma unroll
    for (int db = 0; db < 4; ++db)
#pragma unroll
        for (int g4 = 0; g4 < 4; ++g4) { u32x2 w; w.x = pg8::pk_bf16(o[db][4 * g4] * inv, o[db][4 * g4 + 1] * inv); w.y = pg8::pk_bf16(o[db][4 * g4 + 2] * inv, o[db][4 * g4 + 3] * inv);
            *(u32x2*)(orow + 32 * db + 8 * g4 + 4 * hi) = w; }
    ATT_WAIT_BAR();
}

__device__ __forceinline__ void diff_unit(int h, int j, float lam, const bf16* QD, const bf16* KD, const bf16* VDT, const float* gsub, bf16* OC, LAS unsigned char* lds, int wave, int lane) {
    const int r32 = lane & 31, hi = lane >> 5, m = wave >> 2, qs = wave & 3; const unsigned lds0 = (unsigned)(uintptr_t)lds;
    const int row = 128 * j + 32 * qs + r32, cw = 2 * j + (qs >> 1), NT = 2 * j + 2;
    const char* Kb = (const char*)(KD + (h * 2) * 128); const char* Vb = (const char*)(VDT + (size_t)h * 256 * SEQ);
    diff_stage(Kb, Vb, 0, lds0, wave, lane);
    bf16x8 qf[8];
#pragma unroll
    for (int d0 = 0; d0 < 8; ++d0) qf[d0] = *(const bf16x8*)(QD + (size_t)row * 2048 + (h * 2 + m) * 128 + 16 * d0 + 8 * hi);
#pragma unroll
    for (int d0 = 0; d0 < 8; ++d0) asm volatile("" : "+v"(qf[d0]));
    f32x16 o[8];
#pragma unroll
    for (int db = 0; db < 8; ++db)
#pragma unroll
        for (int r = 0; r < 16; ++r) o[db][r] = 0.f;
    float lsum = 0.f;
    for (int t = 0; t < NT; ++t) {
        ATT_WAIT_BAR();
        const LAS unsigned char* sb = lds + (t & 1) * DIFF_STAGE; int r32o = r32; asm volatile("" : "+v"(r32o));
#if DIFF_PD == 0
        if (t + 1 < NT) diff_stage(Kb, Vb, t + 1, lds0 + ((t + 1) & 1) * DIFF_STAGE, wave, lane);
        if (t <= cw) tile_compute_simple<8, 0, 8>(sb + m * 16384, sb, sb + 32768, qf, o, lsum, r32o, hi);
#else
        bf16x8 fp[DIFF_PD];
        if (t <= cw) {
#pragma unroll
            for (int i = 0; i < DIFF_PD; ++i) fp[i] = frag_load<8, 0>(sb + m * 16384, sb, sb + 32768, i, 0, r32o, (r32o & 15) ^ hi, ((r32o >> 1) & 7) ^ hi); }
        if (t + 1 < NT) diff_stage(Kb, Vb, t + 1, lds0 + ((t + 1) & 1) * DIFF_STAGE, wave, lane);
        if (t <= cw) tile_compute<8, 0, 8, DIFF_PD>(fp, sb + m * 16384, sb, sb + 32768, qf, o, lsum, r32o, hi);
#endif
    }
    lsum += __shfl_xor(lsum, 32);
    ATT_WAIT_BAR();
    LAS float* X = (LAS float*)lds;
    if (m == 1) { const float f = lam / lsum;
#pragma unroll
        for (int db = 0; db < 8; ++db)
#pragma unroll
            for (int r = 0; r < 16; ++r) X[(32 * db + crow(r, hi)) * 128 + 32 * qs + r32] = o[db][r] * f; }
    ATT_WAIT_BAR();
    if (m == 0) { const float inv = 1.0f / lsum; float ss = 0.f;
#pragma unroll
        for (int db = 0; db < 8; ++db)
#pragma unroll
            for (int r = 0; r < 16; ++r) { const float v = o[db][r] * inv - X[(32 * db + crow(r, hi)) * 128 + 32 * qs + r32]; o[db][r] = v; ss += v * v; }
        ss += __shfl_xor(ss, 32);
        const float sc = (1.0f - LAMBDA_INIT) / sqrtf(ss * (1.f / 256.f) + EPS);
        bf16* orow = OC + (size_t)row * 4096 + 2048 + h * 256;
#pragma unroll
        for (int db = 0; db < 8; ++db)
#pragma unroll
            for (int g4 = 0; g4 < 4; ++g4) { const int dv0 = 32 * db + 8 * g4 + 4 * hi; const f32x4 g = *(const f32x4*)(gsub + dv0);
                u32x2 w; w.x = pg8::pk_bf16(o[db][4 * g4] * sc * g.x, o[db][4 * g4 + 1] * sc * g.y); w.y = pg8::pk_bf16(o[db][4 * g4 + 2] * sc * g.z, o[db][4 * g4 + 3] * sc * g.w);
                *(u32x2*)(orow + dv0) = w; } }
    ATT_WAIT_BAR();
}
}

__device__ __forceinline__ int fresh_lane() { int l = (int)__builtin_amdgcn_mbcnt_hi(~0u, __builtin_amdgcn_mbcnt_lo(~0u, 0u)); asm volatile("" : "+v"(l)); return l; }
constexpr int I_IN = (DM / 64) * (DIN / 32), I_UQ = (768 / 64) * (3072 / 32), I_UKV = (512 / 64) * (4096 / 32), I_O = (DM / 64) * (DM / 32), I_G = (DM / 64) * (DFF / 32), I_D = (DFF / 64) * (DM / 32);
constexpr int NG1 = 13000, ND8 = 19000, NU3 = 8000, SPARE1 = 16, SPARE8 = 5;
static_assert(NG1 <= I_G && ND8 <= I_D, "deferred item counts");
__global__ void __launch_bounds__(NWAVES * 64) fwd_kernel(Args A) {
    extern __shared__ __attribute__((aligned(16))) unsigned char lds_raw[];
    LAS unsigned char* lds = (LAS unsigned char*)lds_raw;
    cg::grid_group grid = cg::this_grid();
    const int wave = __builtin_amdgcn_readfirstlane((int)threadIdx.x >> 6);
    const int lane = (int)__builtin_amdgcn_mbcnt_hi(~0u, __builtin_amdgcn_mbcnt_lo(~0u, 0u)), tid = wave * 64 + lane;
    const int G = gridDim.x, bx = blockIdx.x; const int vcu = (G % 8 == 0) ? (bx % 8) * (G / 8) + bx / 8 : bx;
    unsigned char* ws = A.ws;
    const int lo = A.ph_lo, hi = A.ph_hi;
#define IN(k) (lo <= (k) && (k) < hi)
#ifndef PROBE_MASK
#define PROBE_MASK 0
#endif
#define REPS(k) for (int rep_ = 0; rep_ < (((PROBE_MASK >> (k)) & 1) ? 2 : 1); ++rep_)
    volatile LAS unsigned* bst = (volatile LAS unsigned*)(lds + LDS_BYTES - 64);
    if (tid < 2) bst[tid] = 0u;
    __syncthreads();
    XcdBarrier bar; bar.bar = (unsigned*)(ws + WS_BAR); bar.x = 0; bar.st = bst;
    const bool t0 = (tid == 0);
    if (hi - lo > 1) bar = xcd_barrier_post((unsigned*)(ws + WS_BAR), bst, t0);
#define SEAM(k) do { if (IN(k) && IN((k) + 1)) { if ((k) == 0) grid.sync(); else xcd_barrier(bar, t0); } } while (0)
    bf16* XN = (bf16*)(ws + WS_XN);

    if (IN(0)) REPS(0) {
        LAS float* scr = (LAS float*)(lds + wave * 16384);
        const int gw = vcu * NWAVES + wave, NGW = G * NWAVES;
        const int ng1 = (G >= 64) ? NG1 : 0, nd8 = (G >= 64) ? ND8 : 0, nu3 = (G >= 64) ? NU3 : 0, wo0 = (G >= 64) ? 0 : I_O;
        {
            int base = 0;
#define P0_STREAM(W_, K_, N_, WT_, MODE_, FIRST_, CNT_) do { const int b_ = ((gw - base) % NGW + NGW) % NGW; \
                conv_stream(W_, K_, N_, WT_, MODE_, scr, (FIRST_) + b_, (FIRST_) + (CNT_), NGW, lane); base += (CNT_); } while (0)
            P0_STREAM(A.in[5], 768, 3072, (bf16*)(ws + WS_WUQ), 0, 0, I_UQ);
            P0_STREAM(A.in[6], 512, 4096, (bf16*)(ws + WS_WUKV), 0, 0, I_UKV);
            P0_STREAM(A.in[16], DM, DM, (bf16*)(ws + WS_WO), 0, 0, wo0);
            P0_STREAM(A.in[18], DM, DFF, (bf16*)(ws + WS_WGU), 1, ng1, I_G - ng1);
            P0_STREAM(A.in[19], DM, DFF, (bf16*)(ws + WS_WGU), 2, nu3, I_G - nu3);
            P0_STREAM(A.in[20], DFF, DM, (bf16*)(ws + WS_WDN), 0, nd8, I_D - nd8);
            P0_STREAM(A.in[2], DM, DIN, (bf16*)(ws + WS_WIN), 0, 0, I_IN);
#undef P0_STREAM
        }
        { u32x4* pz = (u32x4*)(ws + WS_WIN + (size_t)DIN * DM * 2); const int n16 = (ZLD - DIN) * DM * 2 / 16; const u32x4 z4 = {0u, 0u, 0u, 0u};
            for (int i = vcu * 512 + tid; i < n16; i += G * 512) pz[i] = z4; }
        for (int mrow = gw; mrow < SEQ; mrow += NGW) rms_row_4096(A.in[0] + (size_t)mrow * DM, A.in[1], XN + (size_t)mrow * DM, lane);
    }
    SEAM(0);
    if (IN(1)) REPS(1) {
        const int spare = (G >= 64) ? SPARE1 : 0, Gg = G - spare;
        if (bx < Gg) {
            pg8::Gemm g{XN, (const bf16*)(ws + WS_WIN), SEQ, ZLD, DM}; pg8::StaticOrder S; S.init(SEQ, ZLD, Gg, bx);
            pg8::EpiBf16S E{(bf16*)(ws + WS_Z), ZLD};
            pg8::gemm_phase<pg8::EpiBf16S, pg8::StaticOrder, true, true>(lds, g, S, E, tid);
        } else {
            LAS float* scr = (LAS float*)(lds + wave * 16384);
            const int sw = (bx - Gg) * NWAVES + wave, ns = spare * NWAVES;
            conv_stream(A.in[16], DM, DM, (bf16*)(ws + WS_WO), 0, scr, sw, I_O, ns, lane);
            conv_stream(A.in[18], DM, DFF, (bf16*)(ws + WS_WGU), 1, scr, sw, NG1, ns, lane);
        }
    }
    SEAM(1);
    if (IN(2)) REPS(2) p2_phase(A, lds, vcu, G, tid, wave, lane);
    SEAM(2);
    if (IN(3)) REPS(3) {
        { pg8::Gemm g{(const bf16*)(ws + WS_CQN), (const bf16*)(ws + WS_WUQ), SEQ, 3072, 768}; pg8::StaticOrder S; S.init(SEQ, 3072, G, G - 1 - bx);
          pg8::EpiBf16S E{(bf16*)(ws + WS_QRAW), 3072};
          pg8::gemm_phase<pg8::EpiBf16S, pg8::StaticOrder, true, true>(lds, g, S, E, tid); }
        { pg8::Gemm g{(const bf16*)(ws + WS_CKVN), (const bf16*)(ws + WS_WUKV), SEQ, 4096, 512}; pg8::StaticOrder S; S.init(SEQ, 4096, G, bx);
          pg8::EpiBf16S E{(bf16*)(ws + WS_KVRAW), 4096};
          pg8::gemm_phase<pg8::EpiBf16S, pg8::StaticOrder, true, true>(lds, g, S, E, tid); }
        if (G >= 64 && bx < G / 2)
            conv_stream(A.in[19], DM, DFF, (bf16*)(ws + WS_WGU), 2, (LAS float*)(lds + wave * 16384), bx * NWAVES + wave, NU3, (G / 2) * NWAVES, lane);
    }
    SEAM(3);
    if (IN(4)) REPS(4) p4_phase(A, lds, vcu, G, tid, wave, lane);
    SEAM(4);
    if (IN(5)) {
        float lam;
        { const float* q1 = A.in[11]; const float* k1 = A.in[12]; const float* q2 = A.in[13]; const float* k2 = A.in[14];
          const float s1 = wave_sum(q1[lane] * k1[lane] + q1[lane + 64] * k1[lane + 64]), s2 = wave_sum(q2[lane] * k2[lane] + q2[lane + 64] * k2[lane + 64]);
          lam = __uint_as_float(__builtin_amdgcn_readfirstlane(__float_as_uint(expf(s1) - expf(s2) + LAMBDA_INIT))); }
        const bf16* QA = (const bf16*)(ws + WS_QA); const bf16* KA = (const bf16*)(ws + WS_KA); const bf16* VAT = (const bf16*)(ws + WS_VAT);
        const bf16* QD = (const bf16*)(ws + WS_QD); const bf16* KD = (const bf16*)(ws + WS_KD); const bf16* VDT = (const bf16*)(ws + WS_VDT);
        bf16* OC = (bf16*)(ws + WS_OC);
        REPS(5) for (int p = vcu; p < 256; p += G) {
            { const int h = p >> 5, s = p & 31; att::diff_unit(h, 63 - s, lam, QD, KD, VDT, A.in[15], OC, lds, wave, lane); att::diff_unit(h, s, lam, QD, KD, VDT, A.in[15], OC, lds, wave, lane); }
            { const int h = p >> 4, s = p & 15; att::mla_unit(h, 31 - s, QA, KA, VAT, OC, lds, wave, lane); att::mla_unit(h, s, QA, KA, VAT, OC, lds, wave, lane); }
        }
    }
    SEAM(5);
    if (IN(6)) REPS(6) {
        pg8::Gemm g{(const bf16*)(ws + WS_OC), (const bf16*)(ws + WS_WO), SEQ, DM, DM}; pg8::StaticOrder S; S.init(SEQ, DM, G, bx);
        pg8::EpiResF32 E{A.in[0], A.out, DM};
        pg8::gemm_phase<pg8::EpiResF32, pg8::StaticOrder, true, true>(lds, g, S, E, wave * 64 + fresh_lane());
    }
    SEAM(6);
    if (IN(7)) REPS(7) {
        const int gw = vcu * NWAVES + wave, NGW = G * NWAVES;
        for (int mrow = gw; mrow < SEQ; mrow += NGW) rms_row_4096(A.out + (size_t)mrow * DM, A.in[17], XN + (size_t)mrow * DM, fresh_lane());
    }
    SEAM(7);
    if (IN(8)) REPS(8) {
        const int spare = (G >= 64) ? SPARE8 : 0, Gg = G - spare;
        if (bx < Gg) {
            pg8::Gemm g{XN, (const bf16*)(ws + WS_WGU), SEQ, 2 * DFF, DM}; pg8::StaticOrder S; S.init(SEQ, 2 * DFF, Gg, bx);
            pg8::EpiSwiGLU E{(bf16*)(ws + WS_ACT), DFF};
            pg8::gemm_phase<pg8::EpiSwiGLU, pg8::StaticOrder, true, true>(lds, g, S, E, wave * 64 + fresh_lane());
        } else {
            LAS float* scr = (LAS float*)(lds + wave * 16384);
            conv_stream(A.in[20], DFF, DM, (bf16*)(ws + WS_WDN), 0, scr, (bx - Gg) * NWAVES + wave, ND8, spare * NWAVES, fresh_lane());
        }
    }
    SEAM(8);
    if (IN(9)) REPS(9) {
        pg8::Gemm g{(const bf16*)(ws + WS_ACT), (const bf16*)(ws + WS_WDN), SEQ, DM, DFF}; pg8::StaticOrder S; S.init(SEQ, DM, G, bx);
        pg8::EpiResF32 E{A.out, A.out, DM};
        pg8::gemm_phase<pg8::EpiResF32, pg8::StaticOrder, true, true>(lds, g, S, E, wave * 64 + fresh_lane());
    }
#undef IN
#undef SEAM
}

#ifndef MK_PER_PHASE
#define MK_PER_PHASE 0
#endif
constexpr int N_PHASES = 10;
extern "C" void kernel_launch(void* const* d_in, const int* in_sizes, int n_in, void* d_out, int out_size, void* d_ws, size_t ws_size, hipStream_t stream) {
    static int grid = 0;
    if (grid == 0) {
        if (n_in != 21 || in_sizes[0] != SEQ * DM || out_size != SEQ * DM || ws_size < WS_END) { fprintf(stderr, "kernel_launch: unexpected shapes / workspace (n_in %d, ws %zu, need %zu)\n", n_in, ws_size, (size_t)WS_END); grid = -1; return; }
        int dev = 0, cus = 0, per_cu = 0;
        if (hipGetDevice(&dev) != hipSuccess || hipDeviceGetAttribute(&cus, hipDeviceAttributeMultiprocessorCount, dev) != hipSuccess) { grid = -1; return; }
        if (hipFuncSetAttribute((const void*)fwd_kernel, hipFuncAttributeMaxDynamicSharedMemorySize, LDS_BYTES) != hipSuccess) { fprintf(stderr, "kernel_launch: hipFuncSetAttribute failed\n"); grid = -1; return; }
        if (hipOccupancyMaxActiveBlocksPerMultiprocessor(&per_cu, (const void*)fwd_kernel, NWAVES * 64, LDS_BYTES) != hipSuccess || per_cu < 1) { fprintf(stderr, "kernel_launch: occupancy query gave %d\n", per_cu); per_cu = 1; }
        (void)hipGetLastError();
        grid = cus * per_cu;
    }
    if (grid < 0) return;
    if (hipMemsetAsync((char*)d_ws + WS_BAR, 0, XCD_BAR_WORDS * 4, stream) != hipSuccess) { fprintf(stderr, "kernel_launch: hipMemsetAsync failed\n"); return; }
    Args a{};
    for (int i = 0; i < 21; ++i) a.in[i] = (const float*)d_in[i];
    a.out = (float*)d_out; a.ws = (unsigned char*)d_ws;
    for (int j = 0; j < 64; ++j) a.invf[j] = (float)std::pow(10000.0, -(double)j / 64.0);
#if MK_PER_PHASE
#ifndef HOST_REP_MASK
#define HOST_REP_MASK 0
#endif
    for (int ph = 0; ph < N_PHASES; ++ph) for (int rep = 0; rep < (((HOST_REP_MASK >> ph) & 1) ? 2 : 1); ++rep) { a.ph_lo = ph; a.ph_hi = ph + 1; hipLaunchKernelGGL(fwd_kernel, dim3(grid), dim3(NWAVES * 64), LDS_BYTES, stream, a); }
#else
    a.ph_lo = 0; a.ph_hi = N_PHASES;
    void* args[] = {&a};
    hipError_t e = hipLaunchCooperativeKernel((const void*)fwd_kernel, dim3(grid), dim3(NWAVES * 64), args, LDS_BYTES, stream);
    if (e != hipSuccess) fprintf(stderr, "kernel_launch: cooperative launch failed: %s (grid %d)\n", hipGetErrorString(e), grid);
#endif
}
```

```cpp
#include <hip/hip_runtime.h>
#include <hip/hip_cooperative_groups.h>
#include <cstdio>
#include <cstdint>
#include <cmath>
namespace cg = cooperative_groups;
namespace pg8 {
#define PG8_LAS __attribute__((address_space(3)))
typedef unsigned short bf16_t;
typedef short bf16x8 __attribute__((ext_vector_type(8)));
typedef float f32x4 __attribute__((ext_vector_type(4)));
typedef unsigned u32x4 __attribute__((ext_vector_type(4)));
constexpr int BM = 256, BK = 64, HALF = 128, HTB = HALF * BK * 2  , STAGE_BYTES = 8 * HTB, NXCD = 8, WGM = 4;

__host__ __device__ __forceinline__ int lds_byte(int r, int c) { const int st = (r >> 4) * 2 + (c >> 5), rr = r & 15, cc = c & 31, ob = rr * 64 + cc * 2; return st * 1024 + (ob ^ (((ob >> 9) & 1) << 5)); }
__host__ __device__ __forceinline__ void stage_rc(int b, int& R, int& C) { const int st = b / 1024, sb = b % 1024, swz = sb ^ (((sb >> 9) & 1) << 5); R = (st >> 1) * 16 + swz / 64; C = (st & 1) * 32 + (swz % 64) / 2; }
__host__ __device__ __forceinline__ int perm32(int rho) { const int n = rho >> 4, i = rho & 15; return 8 * (i >> 2) + 4 * n + (i & 3); }

struct Unit { int pm, pn; };
struct Gemm { const bf16_t* A; const bf16_t* Bt; int M, N, K; };

struct StaticOrder {
    int nM, nN, nwg, G, c;
    __host__ __device__ void init(int M, int N, int G_, int c_) { nM = M / BM; nN = N / BM; nwg = nM * nN; G = G_; c = c_; }
    __host__ __device__ bool next(int i, Unit& u) const {
        const long L = (long)i * G + c; if (L >= nwg) return false;
        int wgid = (int)L; { const int q = nwg / NXCD, r = nwg % NXCD, xcd = wgid % NXCD, off = wgid / NXCD; wgid = (xcd < r ? xcd * (q + 1) : r * (q + 1) + (xcd - r) * q) + off; }
        const int nig = WGM * nN, gid = wgid / nig, fm = gid * WGM, gsz = (nM - fm) < WGM ? (nM - fm) : WGM;
        u.pm = fm + ((wgid % nig) % gsz); u.pn = (wgid % nig) / gsz; return true;
    }
    __device__ __forceinline__ void a_ready(const Unit&) const {}
    __device__ __forceinline__ void done(const Unit&) const {}
};

__device__ __forceinline__ unsigned cvt_pk_bf16(float lo, float hi) { unsigned r; asm volatile("v_cvt_pk_bf16_f32 %0, %1, %2" : "=v"(r) : "v"(lo), "v"(hi)); return r; }
typedef float f32x2 __attribute__((ext_vector_type(2)));
template <class Epi, class Sched, bool ALIGN_EPI = false, bool SP2 = false>
__device__ __forceinline__ void gemm_phase(PG8_LAS unsigned char* lds, const Gemm g, const Sched& S, const Epi& E, const int tid_in) {
    const int tid = tid_in, wid = __builtin_amdgcn_readfirstlane(tid >> 6), lane = tid & 63, wr = wid >> 2, wc = wid & 3, fr = lane & 15, fq = lane >> 4;
    const int K = g.K, nt = K / BK;
    unsigned voffA[2], voffB[2];
#pragma unroll
    for (int i = 0; i < 2; ++i) { int R, C; stage_rc(tid * 16 + i * 8192, R, C); const int Rb = Epi::PERM ? ((R & ~31) + perm32(R & 31)) : R;
        voffA[i] = (unsigned)(R * K + C) * 2u; voffB[i] = (unsigned)(Rb * K + C) * 2u; }
    const size_t kstep = (size_t)(BK * 2);
    const size_t hstep = (size_t)HALF * K * 2;
    const size_t tstep = 2 * hstep;
    const unsigned ldsw = (unsigned)wid * 1024u;
    const int aoff = lds_byte(wr * 64 + fr, fq * 8), boff = lds_byte(wc * 32 + fr, fq * 8);
#define PG8_SA(b, h) (((b) * 2 + (h)) * HTB)
#define PG8_SB(b, h) ((4 + (b) * 2 + (h)) * HTB)
#define PG8_STAGE(bufoff, gbase, voff) do { _Pragma("unroll") for (int _i = 0; _i < 2; ++_i) \
        __builtin_amdgcn_global_load_lds((const unsigned*)((const char*)(gbase) + (voff)[_i]), (PG8_LAS unsigned*)(lds + (bufoff) + ldsw + _i * 8192), 16, 0, 0); } while (0)
#define PG8_LDA(dst, b, h) do { _Pragma("unroll") for (int m = 0; m < 4; ++m) _Pragma("unroll") for (int k = 0; k < 2; ++k) dst[m][k] = *(const PG8_LAS bf16x8*)(lds + PG8_SA(b, h) + aoff + m * 2048 + k * 1024); } while (0)
#define PG8_LDB(dst, b, h) do { _Pragma("unroll") for (int n = 0; n < 2; ++n) _Pragma("unroll") for (int k = 0; k < 2; ++k) dst[n][k] = *(const PG8_LAS bf16x8*)(lds + PG8_SB(b, h) + boff + n * 2048 + k * 1024); } while (0)
#define PG8_MMA(ai, bj, At, Bt) do { __builtin_amdgcn_s_setprio(1); _Pragma("unroll") for (int m = 0; m < 4; ++m) _Pragma("unroll") for (int n = 0; n < 2; ++n) _Pragma("unroll") for (int k = 0; k < 2; ++k) \
        acc[ai][bj][m][n] = __builtin_amdgcn_mfma_f32_16x16x32_bf16(Bt[n][k], At[m][k], acc[ai][bj][m][n], 0, 0, 0); __builtin_amdgcn_s_setprio(0); } while (0)
#define PG8_WAIT_V(n) asm volatile("s_waitcnt vmcnt(" #n ")" ::: "memory")
#define PG8_WAIT_L(n) asm volatile("s_waitcnt lgkmcnt(" #n ")" ::: "memory")
#define PG8_BAR __builtin_amdgcn_s_barrier()
#define PG8_SCHED __builtin_amdgcn_sched_barrier(0)
    Unit cur, nxt; int ui = 0;
    if (!S.next(0, cur)) return;
    f32x4 acc[2][2][4][2];
#pragma unroll
    for (int a = 0; a < 2; ++a)
#pragma unroll
        for (int b = 0; b < 2; ++b)
#pragma unroll
            for (int m = 0; m < 4; ++m)
#pragma unroll
                for (int n = 0; n < 2; ++n) acc[a][b][m][n] = (f32x4){0.f, 0.f, 0.f, 0.f};
    bf16x8 At[4][2], B0[2][2], B1[2][2];
    const char* cA = (const char*)g.A + (size_t)cur.pm * tstep; const char* cB = (const char*)g.Bt + (size_t)cur.pn * tstep;
    S.a_ready(cur);
    if constexpr (SP2) {
        PG8_STAGE(PG8_SB(0, 0), cB, voffB); PG8_STAGE(PG8_SB(0, 1), cB + hstep, voffB); PG8_STAGE(PG8_SA(0, 0), cA, voffA); PG8_STAGE(PG8_SA(0, 1), cA + hstep, voffA);
        if (wr == 1) PG8_BAR;
        PG8_WAIT_V(2); PG8_BAR;
        PG8_STAGE(PG8_SB(1, 0), cB + kstep, voffB); PG8_STAGE(PG8_SA(1, 0), cA + kstep, voffA); PG8_STAGE(PG8_SB(1, 1), cB + hstep + kstep, voffB);
        PG8_WAIT_V(6); PG8_BAR;
    } else {
        PG8_STAGE(PG8_SB(0, 0), cB, voffB); PG8_STAGE(PG8_SA(0, 0), cA, voffA); PG8_STAGE(PG8_SB(0, 1), cB + hstep, voffB); PG8_STAGE(PG8_SA(0, 1), cA + hstep, voffA);
        if (wr == 1) PG8_BAR;
        PG8_WAIT_V(4); PG8_BAR;
        PG8_STAGE(PG8_SB(1, 0), cB + kstep, voffB); PG8_STAGE(PG8_SA(1, 0), cA + kstep, voffA); PG8_STAGE(PG8_SB(1, 1), cB + hstep + kstep, voffB);
        PG8_WAIT_V(6); PG8_BAR;
    }
    for (;;) {
        const bool has_next = S.next(ui + 1, nxt);
        const char* nA = has_next ? (const char*)g.A + (size_t)nxt.pm * tstep : cA; const char* nB = has_next ? (const char*)g.Bt + (size_t)nxt.pn * tstep : cB;
        for (int t = 0; t < nt; t += 2) {
            const bool last = (t == nt - 2);
            const char* a1 = cA + (size_t)(t + 1) * kstep;
            const char* a2 = last ? nA : cA + (size_t)(t + 2) * kstep; const char* b2 = last ? nB : cB + (size_t)(t + 2) * kstep;
            const char* a3 = a2 + kstep; const char* b3 = b2 + kstep;
            if (last && has_next) S.a_ready(nxt);
            if constexpr (SP2) {
            PG8_LDB(B0, 0, 0); PG8_LDB(B1, 0, 1); PG8_SCHED; PG8_LDA(At, 0, 0); PG8_STAGE(PG8_SA(1, 1), a1 + hstep, voffA);
            PG8_WAIT_V(8); PG8_WAIT_L(0); PG8_BAR; PG8_MMA(0, 0, At, B0); PG8_MMA(0, 1, At, B1); PG8_BAR; PG8_SCHED;
            PG8_LDA(At, 0, 1); PG8_STAGE(PG8_SB(0, 0), b2, voffB); PG8_STAGE(PG8_SB(0, 1), b2 + hstep, voffB); PG8_STAGE(PG8_SA(0, 0), a2, voffA);
            PG8_WAIT_V(8); PG8_WAIT_L(0); PG8_BAR; PG8_MMA(1, 0, At, B0); PG8_MMA(1, 1, At, B1); PG8_BAR; PG8_SCHED;
            PG8_LDB(B0, 1, 0); PG8_LDB(B1, 1, 1); PG8_SCHED; PG8_LDA(At, 1, 0); PG8_STAGE(PG8_SA(0, 1), a2 + hstep, voffA);
            PG8_WAIT_V(8); PG8_WAIT_L(0); PG8_BAR; PG8_MMA(0, 0, At, B0); PG8_MMA(0, 1, At, B1); PG8_BAR; PG8_SCHED;
            PG8_LDA(At, 1, 1); PG8_STAGE(PG8_SB(1, 0), b3, voffB); PG8_STAGE(PG8_SB(1, 1), b3 + hstep, voffB); PG8_STAGE(PG8_SA(1, 0), a3, voffA);
            PG8_WAIT_V(8); PG8_WAIT_L(0); PG8_BAR; PG8_MMA(1, 0, At, B0); PG8_MMA(1, 1, At, B1); PG8_BAR; PG8_SCHED;
            } else {
            PG8_LDB(B0, 0, 0); PG8_SCHED; PG8_LDA(At, 0, 0); PG8_STAGE(PG8_SA(1, 1), a1 + hstep, voffA);
            PG8_WAIT_L(8); PG8_BAR; PG8_WAIT_L(0); PG8_MMA(0, 0, At, B0); PG8_BAR; PG8_SCHED;
            PG8_LDB(B1, 0, 1); PG8_STAGE(PG8_SB(0, 0), b2, voffB);
            PG8_BAR; PG8_WAIT_L(0); PG8_MMA(0, 1, At, B1); PG8_BAR;
            PG8_LDA(At, 0, 1); PG8_STAGE(PG8_SA(0, 0), a2, voffA);
            PG8_BAR; PG8_WAIT_L(0); PG8_MMA(1, 0, At, B0); PG8_BAR; PG8_SCHED;
            PG8_STAGE(PG8_SB(0, 1), b2 + hstep, voffB);
            PG8_WAIT_V(6); PG8_BAR; PG8_MMA(1, 1, At, B1); PG8_BAR;
            PG8_LDB(B0, 1, 0); PG8_SCHED; PG8_LDA(At, 1, 0); PG8_STAGE(PG8_SA(0, 1), a2 + hstep, voffA);
            PG8_WAIT_L(8); PG8_BAR; PG8_WAIT_L(0); PG8_MMA(0, 0, At, B0); PG8_BAR; PG8_SCHED;
            PG8_LDB(B1, 1, 1); PG8_STAGE(PG8_SB(1, 0), b3, voffB);
            PG8_BAR; PG8_WAIT_L(0); PG8_MMA(0, 1, At, B1); PG8_BAR;
            PG8_LDA(At, 1, 1); PG8_STAGE(PG8_SA(1, 0), a3, voffA);
            PG8_BAR; PG8_WAIT_L(0); PG8_MMA(1, 0, At, B0); PG8_BAR; PG8_SCHED;
            PG8_STAGE(PG8_SB(1, 1), b3 + hstep, voffB);
            PG8_WAIT_V(6); PG8_BAR; PG8_MMA(1, 1, At, B1); PG8_BAR;
            }
        }
        if constexpr (ALIGN_EPI) { if (wr == 0) PG8_BAR; }
        if constexpr (!Epi::AFTER_DRAIN) { E(acc, cur, wr, wc, fr, fq); S.done(cur); }
        if (!has_next) break;
#pragma unroll
        for (int a = 0; a < 2; ++a)
#pragma unroll
            for (int b = 0; b < 2; ++b)
#pragma unroll
                for (int m = 0; m < 4; ++m)
#pragma unroll
                    for (int n = 0; n < 2; ++n) acc[a][b][m][n] = (f32x4){0.f, 0.f, 0.f, 0.f};
        cur = nxt; cA = nA; cB = nB; ++ui;
        if constexpr (ALIGN_EPI) { if (wr == 1) PG8_BAR; }
    }
    PG8_WAIT_V(0);
    if constexpr (!ALIGN_EPI) { if (wr == 0) PG8_BAR; }
    PG8_BAR;
    if constexpr (Epi::AFTER_DRAIN) { E.fused(acc, cur, wr, wc, fr, fq, lds, wid, lane); S.done(cur); }
#undef PG8_SA
#undef PG8_SB
#undef PG8_STAGE
#undef PG8_LDA
#undef PG8_LDB
#undef PG8_MMA
#undef PG8_WAIT_V
#undef PG8_WAIT_L
#undef PG8_BAR
#undef PG8_SCHED
}
}

namespace pg8 {
typedef float f32x2e __attribute__((ext_vector_type(2))); typedef __bf16 bf16x2e __attribute__((ext_vector_type(2)));
__device__ __forceinline__ unsigned pk_bf16(float lo, float hi) { f32x2e v = {lo, hi}; bf16x2e b = __builtin_convertvector(v, bf16x2e); return __builtin_bit_cast(unsigned, b); }
struct EpiBf16S {
    static constexpr bool PERM = true, AFTER_DRAIN = false;
    bf16_t* O; int ldc;
    __device__ __forceinline__ void operator()(const f32x4 (&acc)[2][2][4][2], const Unit& u, int wr, int wc, int fr, int fq) const {
        const int row0 = u.pm * BM + wr * 64 + fr, col0 = u.pn * BM + wc * 32 + 8 * fq;
#pragma unroll
        for (int ai = 0; ai < 2; ++ai)
#pragma unroll
            for (int m = 0; m < 4; ++m) { bf16_t* rowp = O + (size_t)(row0 + ai * HALF + m * 16) * ldc + col0;
#pragma unroll
                for (int bj = 0; bj < 2; ++bj) { const f32x4 v0 = acc[ai][bj][m][0], v1 = acc[ai][bj][m][1];
                    u32x4 w; w.x = pk_bf16(v0[0], v0[1]); w.y = pk_bf16(v0[2], v0[3]); w.z = pk_bf16(v1[0], v1[1]); w.w = pk_bf16(v1[2], v1[3]);
                    *(u32x4*)(rowp + bj * HALF) = w; } }
    }
};
struct EpiResF32 {
    static constexpr bool PERM = false, AFTER_DRAIN = false;
    const float* base; float* out; int ldc;
    __device__ __forceinline__ void operator()(const f32x4 (&acc)[2][2][4][2], const Unit& u, int wr, int wc, int fr, int fq) const {
        const int col0 = u.pn * BM + wc * 32 + 4 * fq;
#pragma unroll
        for (int ai = 0; ai < 2; ++ai)
#pragma unroll
            for (int m = 0; m < 4; ++m) { const int r = u.pm * BM + ai * HALF + wr * 64 + m * 16 + fr; const size_t off = (size_t)r * ldc + col0;
#pragma unroll
                for (int bj = 0; bj < 2; ++bj)
#pragma unroll
                    for (int n = 0; n < 2; ++n) { const f32x4 b = *(const f32x4*)(base + off + bj * HALF + n * 16); *(f32x4*)(out + off + bj * HALF + n * 16) = b + acc[ai][bj][m][n]; } }
    }
};
struct EpiSwiGLU {
    static constexpr bool PERM = true, AFTER_DRAIN = false;
    bf16_t* O; int ldc;
    __device__ __forceinline__ static float act(float g, float u) { return g * u * __builtin_amdgcn_rcpf(1.0f + __builtin_amdgcn_exp2f(-1.4426950408889634f * g)); }
    __device__ __forceinline__ void operator()(const f32x4 (&acc)[2][2][4][2], const Unit& u, int wr, int wc, int fr, int fq) const {
        const int row0 = u.pm * BM + wr * 64 + fr, col0 = u.pn * HALF + wc * 32 + 8 * fq;
#pragma unroll
        for (int ai = 0; ai < 2; ++ai)
#pragma unroll
            for (int m = 0; m < 4; ++m) { bf16_t* rowp = O + (size_t)(row0 + ai * HALF + m * 16) * ldc + col0;
                const f32x4 g0 = acc[ai][0][m][0], g1 = acc[ai][0][m][1], u0 = acc[ai][1][m][0], u1 = acc[ai][1][m][1];
                u32x4 w; w.x = pk_bf16(act(g0[0], u0[0]), act(g0[1], u0[1])); w.y = pk_bf16(act(g0[2], u0[2]), act(g0[3], u0[3]));
                w.z = pk_bf16(act(g1[0], u1[0]), act(g1[1], u1[1])); w.w = pk_bf16(act(g1[2], u1[2]), act(g1[3], u1[3]));
                *(u32x4*)(rowp) = w; }
    }
};
}

#define GAS __attribute__((address_space(1)))
#define LAS __attribute__((address_space(3)))
typedef unsigned short bf16;
typedef unsigned u32x4 __attribute__((ext_vector_type(4)));
typedef unsigned u32x2 __attribute__((ext_vector_type(2)));
typedef float f32x4 __attribute__((ext_vector_type(4)));
typedef short bf16x8 __attribute__((ext_vector_type(8)));
typedef float f32x16 __attribute__((ext_vector_type(16)));
constexpr int SEQ = 8192, DM = 4096, DIN = 7488, ZLD = 7680, DFF = 11008;
constexpr int C_CKV = 768, C_KPE = 1280, C_DQ = 1344, C_DK = 3392, C_DV = 5440;
constexpr float EPS = 1e-6f, LOG2E = 1.4426950408889634f;
constexpr float QSC_MLA = 0.07216878364870323f * LOG2E;
constexpr float QSC_DIFF = 0.08838834764831845f * LOG2E;
constexpr float LAMBDA_INIT = 0.2f;
constexpr int NWAVES = 8;
constexpr int LDS_BYTES = 147456;

constexpr size_t WS_BAR = 0;
constexpr size_t WS_WIN = 16384;
constexpr size_t WS_WUQ = WS_WIN + (size_t)ZLD * DM * 2;
constexpr size_t WS_WUKV = WS_WUQ + (size_t)3072 * 768 * 2;
constexpr size_t WS_WO = WS_WUKV + (size_t)4096 * 512 * 2;
constexpr size_t WS_WGU = WS_WO + (size_t)DM * DM * 2;
constexpr size_t WS_WDN = WS_WGU + (size_t)2 * DFF * DM * 2;
constexpr size_t WS_XN = WS_WDN + (size_t)DM * DFF * 2;
constexpr size_t WS_R1 = WS_XN + (size_t)SEQ * DM * 2;
constexpr size_t WS_Z = WS_R1;
constexpr size_t WS_CQN = WS_Z + (size_t)SEQ * ZLD * 2;
constexpr size_t WS_CKVN = WS_CQN + (size_t)SEQ * 768 * 2;
constexpr size_t WS_QRAW = WS_CKVN + (size_t)SEQ * 512 * 2;
constexpr size_t WS_KVRAW = WS_QRAW + (size_t)SEQ * 3072 * 2;
constexpr size_t WS_R1END = WS_KVRAW + (size_t)SEQ * 4096 * 2;
constexpr size_t WS_QA = WS_R1;
constexpr size_t WS_KA = WS_QA + (size_t)SEQ * 3072 * 2;
constexpr size_t WS_VAT = WS_KA + (size_t)SEQ * 3072 * 2;
static_assert(WS_VAT + (size_t)SEQ * 2048 * 2 <= WS_QRAW, "QA|KA|VAT overlay z|cqn|ckvn only");
constexpr size_t WS_OC = WS_QRAW;
constexpr size_t WS_ACT = WS_R1;
static_assert(WS_ACT + (size_t)SEQ * DFF * 2 <= WS_R1END, "act inside R1");
constexpr size_t WS_QD = WS_R1END;
constexpr size_t WS_KD = WS_QD + (size_t)SEQ * 2048 * 2;
constexpr size_t WS_VDT = WS_KD + (size_t)SEQ * 2048 * 2;
constexpr size_t WS_KPE = WS_VDT + (size_t)SEQ * 2048 * 2;
constexpr size_t WS_END = WS_KPE + (size_t)SEQ * 64 * 2;

struct Args { const float* in[21]; float* out; unsigned char* ws; float invf[64]; int ph_lo, ph_hi; };
static_assert(sizeof(Args) == 21 * 8 + 8 + 8 + 256 + 8, "Args has no padding");

__device__ __forceinline__ float wave_sum(float v) {
#pragma unroll
    for (int o = 1; o < 64; o <<= 1) v += __shfl_xor(v, o);
    return v;
}
__device__ __forceinline__ float bflo(unsigned w) { return __uint_as_float(w << 16); }
__device__ __forceinline__ float bfhi(unsigned w) { return __uint_as_float(w & 0xffff0000u); }
__device__ __forceinline__ void unpack8(const u32x4 a, float (&v)[8]) {
    v[0] = bflo(a.x); v[1] = bfhi(a.x); v[2] = bflo(a.y); v[3] = bfhi(a.y); v[4] = bflo(a.z); v[5] = bfhi(a.z); v[6] = bflo(a.w); v[7] = bfhi(a.w);
}
__device__ __forceinline__ u32x4 pack8(const float (&v)[8]) {
    u32x4 w; w.x = pg8::pk_bf16(v[0], v[1]); w.y = pg8::pk_bf16(v[2], v[3]); w.z = pg8::pk_bf16(v[4], v[5]); w.w = pg8::pk_bf16(v[6], v[7]); return w;
}
__device__ __forceinline__ u32x4 ld16(const bf16* p) { return *(const u32x4*)p; }
__device__ __forceinline__ void st16(bf16* p, u32x4 v) { *(u32x4*)p = v; }
__device__ __forceinline__ void ldg8(const float* g, float (&v)[8]) { const f32x4 a = *(const f32x4*)g, b = *(const f32x4*)(g + 4); v[0] = a.x; v[1] = a.y; v[2] = a.z; v[3] = a.w; v[4] = b.x; v[5] = b.y; v[6] = b.z; v[7] = b.w; }
__device__ __forceinline__ void rope_cs(int pos, float invf, float& c, float& s) {
    const float ang = (float)pos * invf; const double rev = (double)ang * 0.15915494309189535; const float fr = (float)(rev - __builtin_rint(rev));
    c = __builtin_amdgcn_cosf(fr); s = __builtin_amdgcn_sinf(fr);
}

__device__ __forceinline__ void p0_transpose_item(const float* W, int K, int N, bf16* WT, int mode, LAS float* scr, int item, int lane) {
    const int nblk = N / 32, kb = item / nblk, nb = item % nblk, k0 = 64 * kb, n0 = 32 * nb;
    {
        f32x4 t[8]; const int kq = lane >> 3, n4 = (lane & 7) * 4;
#pragma unroll
        for (int i = 0; i < 8; ++i) t[i] = *(const f32x4*)(W + (size_t)(k0 + kq + 8 * i) * N + n0 + n4);
#pragma unroll
        for (int i = 0; i < 8; ++i) { LAS float* d = scr + (kq + 8 * i) * 33 + n4; d[0] = t[i].x; d[1] = t[i].y; d[2] = t[i].z; d[3] = t[i].w; }
    }
    asm volatile("s_waitcnt lgkmcnt(0)" ::: "memory");
    const int c = lane & 7;
    const int rbase = (mode == 0) ? n0 : (((n0 >> 7) << 8) + (n0 & 127) + (mode == 2 ? 128 : 0));
#pragma unroll
    for (int j = 0; j < 4; ++j) { const int n = (lane >> 3) + 8 * j; const LAS float* s = scr + (8 * c) * 33 + n;
        u32x4 o; o.x = pg8::pk_bf16(s[0 * 33], s[1 * 33]); o.y = pg8::pk_bf16(s[2 * 33], s[3 * 33]); o.z = pg8::pk_bf16(s[4 * 33], s[5 * 33]); o.w = pg8::pk_bf16(s[6 * 33], s[7 * 33]);
        *(u32x4*)(WT + (size_t)(rbase + n) * K + k0 + 8 * c) = o; }
    asm volatile("s_waitcnt lgkmcnt(0)" ::: "memory");
}
struct ItemRegs { f32x4 t[8]; };
__device__ __forceinline__ void item_load(ItemRegs& R, const float* W, int N, int item, int lane) {
    const int nblk = N / 32, kb = item / nblk, nb = item % nblk, k0 = 64 * kb, n0 = 32 * nb, kq = lane >> 3, n4 = (lane & 7) * 4;
#pragma unroll
    for (int i = 0; i < 8; ++i) R.t[i] = *(const f32x4*)(W + (size_t)(k0 + kq + 8 * i) * N + n0 + n4);
}
__device__ __forceinline__ void item_store(const ItemRegs& R, int K, int N, bf16* WT, int mode, LAS float* scr, int item, int lane) {
    const int nblk = N / 32, kb = item / nblk, nb = item % nblk, k0 = 64 * kb, n0 = 32 * nb, kq = lane >> 3, n4 = (lane & 7) * 4;
#pragma unroll
    for (int i = 0; i < 8; ++i) { LAS float* d = scr + (kq + 8 * i) * 33 + n4; d[0] = R.t[i].x; d[1] = R.t[i].y; d[2] = R.t[i].z; d[3] = R.t[i].w; }
    asm volatile("s_waitcnt lgkmcnt(0)" ::: "memory");
    const int c = lane & 7;
    const int rbase = (mode == 0) ? n0 : (((n0 >> 7) << 8) + (n0 & 127) + (mode == 2 ? 128 : 0));
#pragma unroll
    for (int j = 0; j < 4; ++j) { const int n = (lane >> 3) + 8 * j; const LAS float* s = scr + (8 * c) * 33 + n;
        u32x4 o; o.x = pg8::pk_bf16(s[0 * 33], s[1 * 33]); o.y = pg8::pk_bf16(s[2 * 33], s[3 * 33]); o.z = pg8::pk_bf16(s[4 * 33], s[5 * 33]); o.w = pg8::pk_bf16(s[6 * 33], s[7 * 33]);
        *(u32x4*)(WT + (size_t)(rbase + n) * K + k0 + 8 * c) = o; }
    asm volatile("s_waitcnt lgkmcnt(0)" ::: "memory");
}
__device__ __forceinline__ void conv_stream(const float* W, int K, int N, bf16* WT, int mode, LAS float* scr, int begin, int end, int stride, int lane) {
    if (begin >= end) return;
    ItemRegs r0, r1, r2; item_load(r0, W, N, begin, lane); if (begin + stride < end) item_load(r1, W, N, begin + stride, lane);
    for (int it = begin; it < end; it += stride) { const int it2 = it + 2 * stride; if (it2 < end) item_load(r2, W, N, it2, lane); item_store(r0, K, N, WT, mode, scr, it, lane); r0 = r1; r1 = r2; }
}
__device__ __forceinline__ void rms_row_4096(const float* xrow, const float* g, bf16* orow, int lane) {
    const f32x4* xr = (const f32x4*)xrow + lane; f32x4 v[16]; float s = 0.f;
#pragma unroll
    for (int j = 0; j < 16; ++j) { v[j] = xr[64 * j]; s += (v[j].x * v[j].x + v[j].y * v[j].y) + (v[j].z * v[j].z + v[j].w * v[j].w); }
    const float rstd = 1.0f / sqrtf(wave_sum(s) * (1.f / 4096.f) + EPS);
    const f32x4* gr = (const f32x4*)g + lane; u32x2* o8 = (u32x2*)orow + lane;
#pragma unroll
    for (int j = 0; j < 16; ++j) { const f32x4 gg = gr[64 * j]; u32x2 w; w.x = pg8::pk_bf16(v[j].x * rstd * gg.x, v[j].y * rstd * gg.y); w.y = pg8::pk_bf16(v[j].z * rstd * gg.z, v[j].w * rstd * gg.w); o8[64 * j] = w; }
}
#define RLX_AGENT __ATOMIC_RELAXED, __HIP_MEMORY_SCOPE_AGENT
#define XB_TMO      128
#define XB_XCNT(j)  (256  + 64 * (j))
#define XB_XSUB(j)  (1280 + 64 * (j))
#define XB_XGEN(j)  (2304 + 64 * (j))
#define XB_TOP      3328
#define XB_TOPGEN   3392
#define XCD_BAR_WORDS 3456
#define XB_SPIN_CAP (1u << 18)

__device__ __forceinline__ unsigned xb_ld(unsigned* p)              { return __hip_atomic_load(p, __ATOMIC_RELAXED, __HIP_MEMORY_SCOPE_AGENT); }
__device__ __forceinline__ unsigned xb_add(unsigned* p, unsigned v) { return __hip_atomic_fetch_add(p, v, __ATOMIC_RELAXED, __HIP_MEMORY_SCOPE_AGENT); }
__device__ __forceinline__ unsigned xb_xcc_id() { return (unsigned)__builtin_amdgcn_s_getreg((3 << 11) | 20) & 0xFu; }
#define XB_SPIN(cond, bar) do { unsigned _sp = 0; while (cond) { __builtin_amdgcn_s_sleep(1); \
    if ((++_sp & 255u) == 0u) { if (xb_ld(&(bar)[XB_TMO])) break; if (_sp > XB_SPIN_CAP) { atomicAdd(&(bar)[XB_TMO], 1u); break; } } } } while (0)

struct XcdBarrier {
    unsigned* bar; unsigned x;
    volatile LAS unsigned* st;
};

__device__ __forceinline__ XcdBarrier xcd_barrier_post(unsigned* bar, volatile LAS unsigned* st, bool t0) {
    XcdBarrier b; b.bar = bar; b.x = xb_xcc_id(); b.st = st;
    if (t0) (void)xb_add(&bar[XB_XCNT(b.x)], 1u);
    return b;
}
__device__ __forceinline__ void xcd_barrier_complete(unsigned* bar, unsigned x, unsigned& nloc, unsigned& nx) {
    const unsigned G = gridDim.x * gridDim.y * gridDim.z;
    unsigned sum, cnt, mine, sp = 0u;
    for (;;) {
        sum = 0u; cnt = 0u; mine = 0u;
#pragma unroll
        for (unsigned j = 0; j < 16; ++j) { const unsigned c = xb_ld(&bar[XB_XCNT(j)]); sum += c; cnt += (c > 0u) ? 1u : 0u; mine = (j == x) ? c : mine; }
        if (sum == G) break;
        __builtin_amdgcn_s_sleep(1);
        if ((++sp & 255u) == 0u) { if (xb_ld(&bar[XB_TMO])) break; if (sp > XB_SPIN_CAP) { atomicAdd(&bar[XB_TMO], 1u); break; } }
    }
    nloc = mine > 0u ? mine : 1u; nx = cnt > 0u ? cnt : 1u;
}

__device__ __forceinline__ void xcd_barrier(const XcdBarrier& b, bool t0) {
    asm volatile("s_waitcnt vmcnt(0)" ::: "memory");
    __syncthreads();
    if (t0) {
        unsigned* bar = b.bar;
        __builtin_amdgcn_s_waitcnt(0);
        unsigned nloc = b.st[0], nx = b.st[1];
        if (nloc == 0u) { xcd_barrier_complete(bar, b.x, nloc, nx); b.st[0] = nloc; b.st[1] = nx; }
        const unsigned old = xb_add(&bar[XB_XSUB(b.x)], 1u);
        const unsigned gen = old / nloc;
        if (old + 1u == (gen + 1u) * nloc) {
            __builtin_amdgcn_fence(__ATOMIC_RELEASE, "agent");
            asm volatile("s_waitcnt vmcnt(0)" ::: "memory");
            const unsigned og = xb_add(&bar[XB_TOP], 1u);
            const unsigned tg = og / nx;
            if (og + 1u == (tg + 1u) * nx) xb_add(&bar[XB_TOPGEN], 1u);
            else XB_SPIN(xb_ld(&bar[XB_TOPGEN]) == tg, bar);
            __builtin_amdgcn_fence(__ATOMIC_ACQUIRE, "agent");
            xb_add(&bar[XB_XGEN(b.x)], 1u);
            asm volatile("s_waitcnt vmcnt(0)" ::: "memory");
        } else {
            XB_SPIN(xb_ld(&bar[XB_XGEN(b.x)]) == gen, bar);
            __builtin_amdgcn_fence(__ATOMIC_ACQUIRE, "agent");
            asm volatile("s_waitcnt vmcnt(0)" ::: "memory");
        }
    }
    __syncthreads();
}

constexpr int TP_PITCH = 1040;
__device__ __forceinline__ void tp_store(LAS const unsigned char* tl, bf16* dst, int s0, int tid) {
#pragma unroll
    for (int k = 0; k < 4; ++k) { const int idx = tid + 512 * k, sg = idx & 3, col = idx >> 2; const LAS unsigned char* p = tl + (8 * sg) * TP_PITCH + 2 * col;
        unsigned short e[8];
#pragma unroll
        for (int i = 0; i < 8; ++i) e[i] = *(const LAS unsigned short*)(p + i * TP_PITCH);
        u32x4 w; w.x = e[0] | ((unsigned)e[1] << 16); w.y = e[2] | ((unsigned)e[3] << 16); w.z = e[4] | ((unsigned)e[5] << 16); w.w = e[6] | ((unsigned)e[7] << 16);
        st16(dst + (size_t)col * SEQ + s0 + 8 * sg, w); }
}

struct P2Row { u32x4 cq0, cq1, ckv, kpe, dq[4], dk[4]; };
__device__ __forceinline__ void p2_load(P2Row& R, const bf16* zr, int lane) {
    const u32x4 z4 = {0u, 0u, 0u, 0u}; const int sub = lane & 15;
    R.cq0 = ld16(zr + 8 * lane); R.cq1 = (lane < 32) ? ld16(zr + 512 + 8 * lane) : z4; R.ckv = ld16(zr + C_CKV + 8 * lane); R.kpe = (lane < 8) ? ld16(zr + C_KPE + 8 * lane) : z4;
#pragma unroll
    for (int rd = 0; rd < 4; ++rd) { const int head = rd * 4 + (lane >> 4); R.dq[rd] = ld16(zr + C_DQ + head * 128 + sub * 8); R.dk[rd] = ld16(zr + C_DK + head * 128 + sub * 8); }
}
__device__ __forceinline__ void p2_phase(const Args& A, LAS unsigned char* lds, int vcu, int G, int tid, int wave, int lane) {
    unsigned char* ws = A.ws;
    const bf16* Z = (const bf16*)(ws + WS_Z); bf16* CQN = (bf16*)(ws + WS_CQN); bf16* CKVN = (bf16*)(ws + WS_CKVN); bf16* KPE = (bf16*)(ws + WS_KPE);
    bf16* QD = (bf16*)(ws + WS_QD); bf16* KD = (bf16*)(ws + WS_KD); bf16* VDT = (bf16*)(ws + WS_VDT);
    const int sub = lane & 15;
    float gq0[8], gq1[8], gkv[8], gdq[8], gdk[8];
    ldg8(A.in[3] + 8 * lane, gq0); ldg8(A.in[3] + 512 + 8 * (lane & 31), gq1); ldg8(A.in[4] + 8 * lane, gkv); ldg8(A.in[9] + 8 * sub, gdq); ldg8(A.in[10] + 8 * sub, gdk);
    float ifr[8];
#pragma unroll
    for (int e = 0; e < 8; ++e) ifr[e] = A.invf[8 * (sub & 7) + e];
    for (int unit = vcu; unit < SEQ / 32; unit += G) {
        const int s0 = unit * 32;
        P2Row cur, nxt;
        p2_load(cur, Z + (size_t)(s0 + wave * 4) * ZLD, lane);
#pragma unroll
        for (int i = 0; i < 4; ++i) {
            const int row = s0 + wave * 4 + i;
            if (i < 3) p2_load(nxt, Z + (size_t)(row + 1) * ZLD, lane);
            {
                float va[8], vb[8]; unpack8(cur.cq0, va); unpack8(cur.cq1, vb); float ss = 0.f;
#pragma unroll
                for (int e = 0; e < 8; ++e) ss += va[e] * va[e] + vb[e] * vb[e];
                const float rstd = 1.0f / sqrtf(wave_sum(ss) * (1.f / 768.f) + EPS);
#pragma unroll
                for (int e = 0; e < 8; ++e) { va[e] = va[e] * rstd * gq0[e]; vb[e] = vb[e] * rstd * gq1[e]; }
                st16(CQN + (size_t)row * 768 + 8 * lane, pack8(va));
                if (lane < 32) st16(CQN + (size_t)row * 768 + 512 + 8 * lane, pack8(vb));
            }
            {
                float va[8]; unpack8(cur.ckv, va); float ss = 0.f;
#pragma unroll
                for (int e = 0; e < 8; ++e) ss += va[e] * va[e];
                const float rstd = 1.0f / sqrtf(wave_sum(ss) * (1.f / 512.f) + EPS);
#pragma unroll
                for (int e = 0; e < 8; ++e) va[e] = va[e] * rstd * gkv[e];
                st16(CKVN + (size_t)row * 512 + 8 * lane, pack8(va));
            }
            if (lane < 8) st16(KPE + (size_t)row * 64 + 8 * lane, cur.kpe);
            float cs[8], sn[8];
#pragma unroll
            for (int e = 0; e < 8; ++e) rope_cs(row, ifr[e], cs[e], sn[e]);
#pragma unroll
            for (int which = 0; which < 2; ++which) {
                bf16* dst = which ? KD : QD; const float osc = which ? 1.0f : QSC_DIFF;
#pragma unroll
                for (int rd = 0; rd < 4; ++rd) {
                    const int head = rd * 4 + (lane >> 4);
                    float v[8]; unpack8(which ? cur.dk[rd] : cur.dq[rd], v); float ss = 0.f;
#pragma unroll
                    for (int e = 0; e < 8; ++e) ss += v[e] * v[e];
                    ss += __shfl_xor(ss, 1); ss += __shfl_xor(ss, 2); ss += __shfl_xor(ss, 4); ss += __shfl_xor(ss, 8);
                    const float rstd = 1.0f / sqrtf(ss * (1.f / 128.f) + EPS);
                    float o[8];
#pragma unroll
                    for (int e = 0; e < 8; ++e) { const float y = v[e] * rstd * (which ? gdk[e] : gdq[e]); const float p = __shfl_xor(y, 8); o[e] = ((sub < 8) ? (y * cs[e] - p * sn[e]) : (y * cs[e] + p * sn[e])) * osc; }
                    st16(dst + (size_t)row * 2048 + head * 128 + sub * 8, pack8(o));
                }
            }
            cur = nxt;
        }
        for (int pass = 0; pass < 4; ++pass) {
            __syncthreads();
#pragma unroll
            for (int k = 0; k < 4; ++k) { const int idx = tid + 512 * k, r = idx >> 6, c = idx & 63;
                *(LAS u32x4*)(lds + r * TP_PITCH + 16 * c) = ld16(Z + (size_t)(s0 + r) * ZLD + C_DV + 512 * pass + 8 * c); }
            __syncthreads();
            tp_store(lds, VDT + (size_t)(512 * pass) * SEQ, s0, tid);
        }
        __syncthreads();
    }
}

struct P4Row { u32x4 q[8], k[8]; };
__device__ __forceinline__ void p4_load(P4Row& R, const bf16* QRAW, const bf16* KVRAW, const bf16* KPE, int row, int lane) {
    const u32x4 z4 = {0u, 0u, 0u, 0u}; const int sub = lane & 31, hsel = lane >> 5; const bool act = sub < 24;
    const u32x4 kpe = (sub >= 16 && act) ? ld16(KPE + (size_t)row * 64 + (sub - 16) * 8) : z4;
#pragma unroll
    for (int rd = 0; rd < 8; ++rd) { const int head = 2 * rd + hsel;
        R.q[rd] = act ? ld16(QRAW + (size_t)row * 3072 + head * 192 + sub * 8) : z4;
        R.k[rd] = (sub < 16) ? ld16(KVRAW + (size_t)row * 4096 + head * 256 + sub * 8) : kpe; }
}
__device__ __forceinline__ void p4_phase(const Args& A, LAS unsigned char* lds, int vcu, int G, int tid, int wave, int lane) {
    unsigned char* ws = A.ws;
    const bf16* QRAW = (const bf16*)(ws + WS_QRAW); const bf16* KVRAW = (const bf16*)(ws + WS_KVRAW); const bf16* KPE = (const bf16*)(ws + WS_KPE);
    bf16* QA = (bf16*)(ws + WS_QA); bf16* KA = (bf16*)(ws + WS_KA); bf16* VAT = (bf16*)(ws + WS_VAT);
    const int sub = lane & 31, hsel = lane >> 5; const bool act = sub < 24; const int subc = act ? sub : 0;
    const bool rlo = (sub >= 16 && sub < 20), rhi = (sub >= 20 && sub < 24);
    float gq[8], gk[8]; ldg8(A.in[7] + 8 * subc, gq); ldg8(A.in[8] + 8 * subc, gk);
    float ifr[8];
#pragma unroll
    for (int e = 0; e < 8; ++e) ifr[e] = A.invf[2 * (8 * (sub & 3) + e)];
    for (int unit = vcu; unit < SEQ / 32; unit += G) {
        const int s0 = unit * 32;
        for (int i = 0; i < 4; ++i) {
            const int row = s0 + wave * 4 + i;
            P4Row cur; { int lo_ = lane; asm volatile("" : "+v"(lo_)); p4_load(cur, QRAW, KVRAW, KPE, row, lo_); }
            float cs[8], sn[8];
#pragma unroll
            for (int e = 0; e < 8; ++e) rope_cs(row, ifr[e], cs[e], sn[e]);
#pragma unroll
            for (int which = 0; which < 2; ++which) {
                bf16* dst = which ? KA : QA; const float osc = which ? 1.0f : QSC_MLA;
#pragma unroll
                for (int rd = 0; rd < 8; ++rd) {
                    const int head = 2 * rd + hsel;
                    float v[8]; unpack8(which ? cur.k[rd] : cur.q[rd], v); float ss = 0.f;
#pragma unroll
                    for (int e = 0; e < 8; ++e) ss += v[e] * v[e];
                    ss += __shfl_xor(ss, 1); ss += __shfl_xor(ss, 2); ss += __shfl_xor(ss, 4); ss += __shfl_xor(ss, 8); ss += __shfl_xor(ss, 16);
                    const float rstd = 1.0f / sqrtf(ss * (1.f / 192.f) + EPS);
                    float o[8];
#pragma unroll
                    for (int e = 0; e < 8; ++e) { const float y = v[e] * rstd * (which ? gk[e] : gq[e]); const float p = __shfl_xor(y, 4);
                        float r = y; if (rlo) r = y * cs[e] - p * sn[e]; if (rhi) r = y * cs[e] + p * sn[e]; o[e] = r * osc; }
                    if (act) st16(dst + (size_t)row * 3072 + head * 192 + sub * 8, pack8(o));
                }
            }
        }
        for (int pass = 0; pass < 4; ++pass) {
            __syncthreads();
#pragma unroll
            for (int k = 0; k < 4; ++k) { const int idx = tid + 512 * k, r = idx >> 6, c = idx & 63, hl = c >> 4, cc = c & 15;
                *(LAS u32x4*)(lds + r * TP_PITCH + 16 * c) = ld16(KVRAW + (size_t)(s0 + r) * 4096 + (4 * pass + hl) * 256 + 128 + 8 * cc); }
            __syncthreads();
            tp_store(lds, VAT + (size_t)(512 * pass) * SEQ, s0, tid);
        }
        __syncthreads();
    }
}

namespace att {
__device__ __forceinline__ int swap23(int i) { return (i & ~12) | ((i & 4) << 1) | ((i & 8) >> 1); }
__device__ __forceinline__ void glds16(const void* gsrc, unsigned lds_dst) { unsigned keep;
    asm volatile("s_mov_b32 %0, m0\n\ts_mov_b32 m0, %2\n\ts_nop 0\n\tglobal_load_lds_dwordx4 %1, off\n\ts_mov_b32 m0, %0" : "=&s"(keep) : "v"(gsrc), "s"(lds_dst) : "memory"); }
#define ATT_WAIT_BAR() asm volatile("s_waitcnt vmcnt(0) lgkmcnt(0)\n\ts_barrier" ::: "memory")
__device__ __forceinline__ int crow(int r, int hi) { return (r & 3) + 8 * (r >> 2) + 4 * hi; }

#define ATT_SB() do { asm volatile("" ::: "memory"); __builtin_amdgcn_sched_barrier(0); } while (0)
template <int ND_A, int ND_B>
__device__ __forceinline__ bf16x8 frag_load(const LAS unsigned char* kA, const LAS unsigned char* kB, const LAS unsigned char* vt, int e, int kb, int r32, int xk, int xv) {
    constexpr int ND = ND_A + ND_B;
    if (e < ND_A) return *(const LAS bf16x8*)(kA + (32 * kb + r32) * 256 + (((2 * e) ^ xk) << 4));
    if (e < ND) return *(const LAS bf16x8*)(kB + (32 * kb + r32) * 128 + (((2 * (e - ND_A)) ^ xv) << 4));
    const int db = (e - ND) >> 1, ss = (e - ND) & 1;
    return *(const LAS bf16x8*)(vt + (32 * db + r32) * 128 + (((4 * kb + 2 * ss) ^ xv) << 4));
}
template <int ND_A, int ND_B, int NDB, int PD>
__device__ __forceinline__ void tile_compute(const bf16x8 (&fpre)[PD], const LAS unsigned char* kA, const LAS unsigned char* kB, const LAS unsigned char* vt, const bf16x8* qf, f32x16* o, float& lsum, int r32, int hi) {
    constexpr int ND = ND_A + ND_B, TOT = ND + 2 * NDB;
    bf16x8 f[2][TOT + PD];
#pragma unroll
    for (int i = 0; i < PD; ++i) f[0][i] = fpre[i];
    const int r32in = r32;
#pragma unroll
    for (int kb = 0; kb < 2; ++kb) {
        int r32 = r32in; asm volatile("" : "+v"(r32));
        const int xk = (r32 & 15) ^ hi, xv = ((r32 >> 1) & 7) ^ hi;
        f32x16 s = {0.f, 0.f, 0.f, 0.f, 0.f, 0.f, 0.f, 0.f, 0.f, 0.f, 0.f, 0.f, 0.f, 0.f, 0.f, 0.f};
#pragma unroll
        for (int e = 0; e < ND; ++e) {
            f[kb][e + PD] = frag_load<ND_A, ND_B>(kA, kB, vt, e + PD, kb, r32, xk, xv);
            s = __builtin_amdgcn_mfma_f32_32x32x16_bf16(f[kb][e], qf[e], s, 0, 0, 0);
            ATT_SB();
        }
        float la = 0.f, lb = 0.f; u32x4 w0, w1;
        { const float p0 = __builtin_amdgcn_exp2f(s[0]), p1 = __builtin_amdgcn_exp2f(s[1]), p2 = __builtin_amdgcn_exp2f(s[2]), p3 = __builtin_amdgcn_exp2f(s[3]); la += p0 + p2; lb += p1 + p3; w0.x = pg8::pk_bf16(p0, p1); w0.y = pg8::pk_bf16(p2, p3); }
        { const float p0 = __builtin_amdgcn_exp2f(s[4]), p1 = __builtin_amdgcn_exp2f(s[5]), p2 = __builtin_amdgcn_exp2f(s[6]), p3 = __builtin_amdgcn_exp2f(s[7]); la += p0 + p2; lb += p1 + p3; w0.z = pg8::pk_bf16(p0, p1); w0.w = pg8::pk_bf16(p2, p3); }
        { const float p0 = __builtin_amdgcn_exp2f(s[8]), p1 = __builtin_amdgcn_exp2f(s[9]), p2 = __builtin_amdgcn_exp2f(s[10]), p3 = __builtin_amdgcn_exp2f(s[11]); la += p0 + p2; lb += p1 + p3; w1.x = pg8::pk_bf16(p0, p1); w1.y = pg8::pk_bf16(p2, p3); }
        { const float p0 = __builtin_amdgcn_exp2f(s[12]), p1 = __builtin_amdgcn_exp2f(s[13]), p2 = __builtin_amdgcn_exp2f(s[14]), p3 = __builtin_amdgcn_exp2f(s[15]); la += p0 + p2; lb += p1 + p3; w1.z = pg8::pk_bf16(p0, p1); w1.w = pg8::pk_bf16(p2, p3); }
        lsum += la + lb;
        const bf16x8 pb0 = __builtin_bit_cast(bf16x8, w0), pb1 = __builtin_bit_cast(bf16x8, w1);
        ATT_SB();
#pragma unroll
        for (int e = ND; e < TOT; ++e) {
            if (e + PD < TOT) f[kb][e + PD] = frag_load<ND_A, ND_B>(kA, kB, vt, e + PD, kb, r32, xk, xv);
            else if (kb == 0) f[1][e + PD - TOT] = frag_load<ND_A, ND_B>(kA, kB, vt, e + PD - TOT, 1, r32, xk, xv);
            const int db = (e - ND) >> 1;
            o[db] = __builtin_amdgcn_mfma_f32_32x32x16_bf16(f[kb][e], ((e - ND) & 1) ? pb1 : pb0, o[db], 0, 0, 0);
            ATT_SB();
        }
    }
}

#ifndef MLA_PD
#define MLA_PD 4
#endif
template <int BUF>
__device__ __forceinline__ bf16x8 mla_frag(const LAS unsigned char* const (&ka)[12], const LAS unsigned char* const (&va)[4], int e, int kb) {
    if (e < 8) return *(const LAS bf16x8*)(ka[e] + BUF * 40960 + kb * 8192);
    if (e < 12) return *(const LAS bf16x8*)(ka[e] + BUF * 40960 + kb * 4096);
    return *(const LAS bf16x8*)(va[2 * kb + ((e - 12) & 1)] + BUF * 40960 + ((e - 12) >> 1) * 4096);
}
template <int BUF>
__device__ __forceinline__ void mla_tile(const bf16x8 (&fpre)[MLA_PD], const LAS unsigned char* const (&ka)[12], const LAS unsigned char* const (&va)[4], const bf16x8* qf, f32x16* o, float& lsum) {
    constexpr int ND = 12, TOT = 20, PD = MLA_PD;
    bf16x8 f[2][TOT + PD];
#pragma unroll
    for (int i = 0; i < PD; ++i) f[0][i] = fpre[i];
#pragma unroll
    for (int kb = 0; kb < 2; ++kb) {
        f32x16 s = {0.f, 0.f, 0.f, 0.f, 0.f, 0.f, 0.f, 0.f, 0.f, 0.f, 0.f, 0.f, 0.f, 0.f, 0.f, 0.f};
#pragma unroll
        for (int e = 0; e < ND; ++e) {
            f[kb][e + PD] = mla_frag<BUF>(ka, va, e + PD, kb);
            s = __builtin_amdgcn_mfma_f32_32x32x16_bf16(f[kb][e], qf[e], s, 0, 0, 0);
            ATT_SB();
        }
        float la = 0.f, lb = 0.f; u32x4 w0, w1;
        { const float p0 = __builtin_amdgcn_exp2f(s[0]), p1 = __builtin_amdgcn_exp2f(s[1]), p2 = __builtin_amdgcn_exp2f(s[2]), p3 = __builtin_amdgcn_exp2f(s[3]); la += p0 + p2; lb += p1 + p3; w0.x = pg8::pk_bf16(p0, p1); w0.y = pg8::pk_bf16(p2, p3); }
        { const float p0 = __builtin_amdgcn_exp2f(s[4]), p1 = __builtin_amdgcn_exp2f(s[5]), p2 = __builtin_amdgcn_exp2f(s[6]), p3 = __builtin_amdgcn_exp2f(s[7]); la += p0 + p2; lb += p1 + p3; w0.z = pg8::pk_bf16(p0, p1); w0.w = pg8::pk_bf16(p2, p3); }
        { const float p0 = __builtin_amdgcn_exp2f(s[8]), p1 = __builtin_amdgcn_exp2f(s[9]), p2 = __builtin_amdgcn_exp2f(s[10]), p3 = __builtin_amdgcn_exp2f(s[11]); la += p0 + p2; lb += p1 + p3; w1.x = pg8::pk_bf16(p0, p1); w1.y = pg8::pk_bf16(p2, p3); }
        { const float p0 = __builtin_amdgcn_exp2f(s[12]), p1 = __builtin_amdgcn_exp2f(s[13]), p2 = __builtin_amdgcn_exp2f(s[14]), p3 = __builtin_amdgcn_exp2f(s[15]); la += p0 + p2; lb += p1 + p3; w1.z = pg8::pk_bf16(p0, p1); w1.w = pg8::pk_bf16(p2, p3); }
        lsum += la + lb;
        const bf16x8 pb0 = __builtin_bit_cast(bf16x8, w0), pb1 = __builtin_bit_cast(bf16x8, w1);
        ATT_SB();
#pragma unroll
        for (int e = ND; e < TOT; ++e) {
            if (e + PD < TOT) f[kb][e + PD] = mla_frag<BUF>(ka, va, e + PD, kb);
            else if (kb == 0) f[1][e + PD - TOT] = mla_frag<BUF>(ka, va, e + PD - TOT, 1);
            const int db = (e - ND) >> 1;
            o[db] = __builtin_amdgcn_mfma_f32_32x32x16_bf16(f[kb][e], ((e - ND) & 1) ? pb1 : pb0, o[db], 0, 0, 0);
            ATT_SB();
        }
    }
}

template <int ND_A, int ND_B, int NDB>
__device__ __forceinline__ void tile_compute_simple(const LAS unsigned char* kA, const LAS unsigned char* kB, const LAS unsigned char* vt, const bf16x8* qf, f32x16* o, float& lsum, int r32, int hi) {
    static_assert(ND_B == 0, "simple form: one K region");
    const int xk = (r32 & 15) ^ hi, xv = ((r32 >> 1) & 7) ^ hi;
#pragma unroll
    for (int kb = 0; kb < 2; ++kb) {
        f32x16 s = {0.f, 0.f, 0.f, 0.f, 0.f, 0.f, 0.f, 0.f, 0.f, 0.f, 0.f, 0.f, 0.f, 0.f, 0.f, 0.f};
        const LAS unsigned char* ka = kA + (32 * kb + r32) * 256;
        bf16x8 a = *(const LAS bf16x8*)(ka + ((0 ^ xk) << 4));
#pragma unroll
        for (int d0 = 0; d0 < ND_A; ++d0) { bf16x8 an = a; if (d0 + 1 < ND_A) an = *(const LAS bf16x8*)(ka + (((2 * (d0 + 1)) ^ xk) << 4));
            s = __builtin_amdgcn_mfma_f32_32x32x16_bf16(a, qf[d0], s, 0, 0, 0); a = an; __builtin_amdgcn_sched_barrier(0); }
        const LAS unsigned char* vr = vt + r32 * 128;
        bf16x8 v0 = *(const LAS bf16x8*)(vr + (((4 * kb) ^ xv) << 4)), v1 = *(const LAS bf16x8*)(vr + (((4 * kb + 2) ^ xv) << 4));
        float p[16];
#pragma unroll
        for (int r = 0; r < 16; ++r) { p[r] = __builtin_amdgcn_exp2f(s[r]); lsum += p[r]; }
        u32x4 w0, w1; w0.x = pg8::pk_bf16(p[0], p[1]); w0.y = pg8::pk_bf16(p[2], p[3]); w0.z = pg8::pk_bf16(p[4], p[5]); w0.w = pg8::pk_bf16(p[6], p[7]);
        w1.x = pg8::pk_bf16(p[8], p[9]); w1.y = pg8::pk_bf16(p[10], p[11]); w1.z = pg8::pk_bf16(p[12], p[13]); w1.w = pg8::pk_bf16(p[14], p[15]);
        const bf16x8 pb0 = __builtin_bit_cast(bf16x8, w0), pb1 = __builtin_bit_cast(bf16x8, w1);
        __builtin_amdgcn_sched_barrier(0);
#pragma unroll
        for (int db = 0; db < NDB; ++db) { bf16x8 n0 = v0, n1 = v1;
            if (db + 1 < NDB) { n0 = *(const LAS bf16x8*)(vr + (db + 1) * 4096 + (((4 * kb) ^ xv) << 4)); n1 = *(const LAS bf16x8*)(vr + (db + 1) * 4096 + (((4 * kb + 2) ^ xv) << 4)); }
            o[db] = __builtin_amdgcn_mfma_f32_32x32x16_bf16(v0, pb0, o[db], 0, 0, 0); o[db] = __builtin_amdgcn_mfma_f32_32x32x16_bf16(v1, pb1, o[db], 0, 0, 0); v0 = n0; v1 = n1; __builtin_amdgcn_sched_barrier(0); }
    }
}

constexpr int MLA_STAGE = 40960, DIFF_STAGE = 65536;
#ifndef DIFF_PD
#define DIFF_PD 0
#endif
__device__ __forceinline__ void glds16s(unsigned voff, const void* sbase, unsigned lds_dst) { unsigned keep;
    asm volatile("s_nop 3\n\ts_mov_b32 %0, m0\n\ts_mov_b32 m0, %3\n\ts_nop 0\n\tglobal_load_lds_dwordx4 %1, %2\n\ts_mov_b32 m0, %0" : "=&s"(keep) : "v"(voff), "s"(sbase), "s"(lds_dst) : "memory"); }
__device__ __forceinline__ void mla_stage(const char* Kb, const char* Vb, int t, unsigned dst, int wave, int lane) {
    asm volatile("" : "+v"(lane));
    const unsigned q = lane >> 4, g3 = lane >> 3;
    const unsigned Bn = ((lane & 15) ^ q) * 16, Br = ((lane & 7) ^ q) * 16;
    const int w0 = wave & 1, w1 = (wave >> 1) & 1, w2 = wave >> 2;
    const char* kbase = Kb + (size_t)(64 * t + 32 * w2 + 16 * w1 + 4 * w0) * 6144;
#pragma unroll
    for (int j = 0; j < 2; ++j)
        glds16s(q * 6144 + (Bn ^ (unsigned)(128 * w0 + 64 * j)), kbase + (size_t)(8 * j) * 6144, (unsigned)__builtin_amdgcn_readfirstlane(dst + (2 * wave + j) * 1024));
    glds16s((8 * (lane >> 5) + (g3 & 3)) * 6144 + (Br ^ (unsigned)(64 * w0)), kbase + 256, (unsigned)__builtin_amdgcn_readfirstlane(dst + 16384 + wave * 1024));
    const char* vbase = Vb + (size_t)(2 * wave) * 8 * (SEQ * 2) + t * 128;
#pragma unroll
    for (int j = 0; j < 2; ++j)
        glds16s(g3 * (SEQ * 2) + (Br ^ (unsigned)(64 * j)), vbase + (size_t)j * 8 * (SEQ * 2), (unsigned)__builtin_amdgcn_readfirstlane(dst + 24576 + (2 * wave + j) * 1024));
}
__device__ __forceinline__ void diff_stage(const char* Kb, const char* Vb, int t, unsigned dst, int wave, int lane) {
    asm volatile("" : "+v"(lane));
    const unsigned q = lane >> 4;
    if (wave < 4) {
        const unsigned A = q * 4096, B = ((lane & 15) ^ q) * 16;
        const char* base = Kb + (wave >> 1) * 256 + (size_t)(64 * t + 32 * (wave & 1)) * 4096;
#pragma unroll
        for (int k = 0; k < 8; ++k) { const int Kk = 16 * (k >> 2) + 8 * (k & 1) + 4 * ((k >> 1) & 1);
            glds16s(A + (B ^ (unsigned)(64 * (k & 3))), base + (size_t)Kk * 4096, (unsigned)__builtin_amdgcn_readfirstlane(dst + (wave * 8 + k) * 1024)); }
    } else {
        const unsigned A = (lane >> 3) * (SEQ * 2), B = ((lane & 7) ^ q) * 16;
        const char* base = Vb + (size_t)(wave - 4) * 64 * (SEQ * 2) + t * 128;
#pragma unroll
        for (int k = 0; k < 8; ++k)
            glds16s(A + (B ^ (unsigned)(64 * (k & 1))), base + (size_t)k * 8 * (SEQ * 2), (unsigned)__builtin_amdgcn_readfirstlane(dst + (wave * 8 + k) * 1024));
    }
}

__device__ __forceinline__ void mla_unit(int h, int qb, const bf16* QA, const bf16* KA, const bf16* VAT, bf16* OC, LAS unsigned char* lds, int wave, int lane) {
    const int r32 = lane & 31, hi = lane >> 5; const unsigned lds0 = (unsigned)(uintptr_t)lds;
    const int row = 256 * qb + 32 * wave + r32, cw = 4 * qb + (wave >> 1), NT = 4 * qb + 4;
    const char* Kb = (const char*)(KA + h * 192); const char* Vb = (const char*)(VAT + (size_t)h * 128 * SEQ);
    mla_stage(Kb, Vb, 0, lds0, wave, lane);
    bf16x8 qf[12];
#pragma unroll
    for (int d0 = 0; d0 < 12; ++d0) qf[d0] = *(const bf16x8*)(QA + (size_t)row * 3072 + h * 192 + 16 * d0 + 8 * hi);
#pragma unroll
    for (int d0 = 0; d0 < 12; ++d0) asm volatile("" : "+v"(qf[d0]));
    f32x16 o[4];
#pragma unroll
    for (int db = 0; db < 4; ++db)
#pragma unroll
        for (int r = 0; r < 16; ++r) o[db][r] = 0.f;
    float lsum = 0.f;
    const LAS unsigned char* ka[12]; const LAS unsigned char* va[4];
    { const int xk = (r32 & 15) ^ hi, xv = ((r32 >> 1) & 7) ^ hi;
#pragma unroll
      for (int d0 = 0; d0 < 8; ++d0) ka[d0] = lds + r32 * 256 + (((2 * d0) ^ xk) << 4);
#pragma unroll
      for (int d0 = 0; d0 < 4; ++d0) ka[8 + d0] = lds + 16384 + r32 * 128 + (((2 * d0) ^ xv) << 4);
#pragma unroll
      for (int i = 0; i < 4; ++i) va[i] = lds + 24576 + r32 * 128 + (((4 * (i >> 1) + 2 * (i & 1)) ^ xv) << 4); }
#define MLA_BODY(BUF_, T_) do { const int t_ = (T_); ATT_WAIT_BAR(); bf16x8 fp[MLA_PD]; \
        if (t_ <= cw) { _Pragma("unroll") for (int i_ = 0; i_ < MLA_PD; ++i_) fp[i_] = mla_frag<BUF_>(ka, va, i_, 0); } \
        if (t_ + 1 < NT) mla_stage(Kb, Vb, t_ + 1, lds0 + (1 - (BUF_)) * MLA_STAGE, wave, lane); \
        if (t_ <= cw) mla_tile<BUF_>(fp, ka, va, qf, o, lsum); } while (0)
    for (int t = 0; t < NT; t += 2) { MLA_BODY(0, t); MLA_BODY(1, t + 1); }
#undef MLA_BODY
    lsum += __shfl_xor(lsum, 32);
    const float inv = 1.0f / lsum;
    bf16* orow = OC + (size_t)row * 4096 + h * 128;
#pragma unroll
    for (int db = 0; db < 4; ++db)
#pragma unroll
        for (int g4 = 0; g4 < 4; ++g4) { u32x2 w; w.x = pg8::pk_bf16(o[db][4 * g4] * inv, o[db][4 * g4 + 1] * inv); w.y = pg8::pk_bf16(o[db][4 * g4 + 2] * inv, o[db][4 * g4 + 3] * inv);
            *(u32x2*)(orow + 32 * db + 8 * g4 + 4 * hi) = w; }
    ATT_WAIT_BAR();
}

__device__ __forceinline__ void diff_unit(int h, int j, float lam, const bf16* QD, const bf16* KD, const bf16* VDT, const float* gsub, bf16* OC, LAS unsigned char* lds, int wave, int lane) {
    const int r32 = lane & 31, hi = lane >> 5, m = wave >> 2, qs = wave & 3; const unsigned lds0 = (unsigned)(uintptr_t)lds;
    const int row = 128 * j + 32 * qs + r32, cw = 2 * j + (qs >> 1), NT = 2 * j + 2;
    const char* Kb = (const char*)(KD + (h * 2) * 128); const char* Vb = (const char*)(VDT + (size_t)h * 256 * SEQ);
    diff_stage(Kb, Vb, 0, lds0, wave, lane);
    bf16x8 qf[8];
#pragma unroll
    for (int d0 = 0; d0 < 8; ++d0) qf[d0] = *(const bf16x8*)(QD + (size_t)row * 2048 + (h * 2 + m) * 128 + 16 * d0 + 8 * hi);
#pragma unroll
    for (int d0 = 0; d0 < 8; ++d0) asm volatile("" : "+v"(qf[d0]));
    f32x16 o[8];
#pragma unroll
    for (int db = 0; db < 8; ++db)
#pragma unroll
        for (int r = 0; r < 16; ++r) o[db][r] = 0.f;
    float lsum = 0.f;
    for (int t = 0; t < NT; ++t) {
        ATT_WAIT_BAR();
        const LAS unsigned char* sb = lds + (t & 1) * DIFF_STAGE; int r32o = r32; asm volatile("" : "+v"(r32o));
#if DIFF_PD == 0
        if (t + 1 < NT) diff_stage(Kb, Vb, t + 1, lds0 + ((t + 1) & 1) * DIFF_STAGE, wave, lane);
        if (t <= cw) tile_compute_simple<8, 0, 8>(sb + m * 16384, sb, sb + 32768, qf, o, lsum, r32o, hi);
#else
        bf16x8 fp[DIFF_PD];
        if (t <= cw) {
#pragma unroll
            for (int i = 0; i < DIFF_PD; ++i) fp[i] = frag_load<8, 0>(sb + m * 16384, sb, sb + 32768, i, 0, r32o, (r32o & 15) ^ hi, ((r32o >> 1) & 7) ^ hi); }
        if (t + 1 < NT) diff_stage(Kb, Vb, t + 1, lds0 + ((t + 1) & 1) * DIFF_STAGE, wave, lane);
        if (t <= cw) tile_compute<8, 0, 8, DIFF_PD>(fp, sb + m * 16384, sb, sb + 32768, qf, o, lsum, r32o, hi);
#endif
    }
    lsum += __shfl_xor(lsum, 32);
    ATT_WAIT_BAR();
    LAS float* X = (LAS float*)lds;
    if (m == 1) { const float f = lam / lsum;
#pragma unroll
        for (int db = 0; db < 8; ++db)
#pragma unroll
            for (int r = 0; r < 16; ++r) X[(32 * db + crow(r, hi)) * 128 + 32 * qs + r32] = o[db][r] * f; }
    ATT_WAIT_BAR();
    if (m == 0) { const float inv = 1.0f / lsum; float ss = 0.f;
#pragma unroll
        for (int db = 0; db < 8; ++db)
#pragma unroll
            for (int r = 0; r < 16; ++r) { const float v = o[db][r] * inv - X[(32 * db + crow(r, hi)) * 128 + 32 * qs + r32]; o[db][r] = v; ss += v * v; }
        ss += __shfl_xor(ss, 32);
        const float sc = (1.0f - LAMBDA_INIT) / sqrtf(ss * (1.f / 256.f) + EPS);
        bf16* orow = OC + (size_t)row * 4096 + 2048 + h * 256;
#pragma unroll
        for (int db = 0; db < 8; ++db)
#pragma unroll
            for (int g4 = 0; g4 < 4; ++g4) { const int dv0 = 32 * db + 8 * g4 + 4 * hi; const f32x4 g = *(const f32x4*)(gsub + dv0);
                u32x2 w; w.x = pg8::pk_bf16(o[db][4 * g4] * sc * g.x, o[db][4 * g4 + 1] * sc * g.y); w.y = pg8::pk_bf16(o[db][4 * g4 + 2] * sc * g.z, o[db][4 * g4 + 3] * sc * g.w);
                *(u32x2*)(orow + dv0) = w; } }
    ATT_WAIT_BAR();
}
}

__device__ __forceinline__ int fresh_lane() { int l = (int)__builtin_amdgcn_mbcnt_hi(~0u, __builtin_amdgcn_mbcnt_lo(~0u, 0u)); asm volatile("" : "+v"(l)); return l; }
constexpr int I_IN = (DM / 64) * (DIN / 32), I_UQ = (768 / 64) * (3072 / 32), I_UKV = (512 / 64) * (4096 / 32), I_O = (DM / 64) * (DM / 32), I_G = (DM / 64) * (DFF / 32), I_D = (DFF / 64) * (DM / 32);
constexpr int NG1 = 13000, ND8 = 19000, NU3 = 8000, SPARE1 = 16, SPARE8 = 5;
static_assert(NG1 <= I_G && ND8 <= I_D, "deferred item counts");
__global__ void __launch_bounds__(NWAVES * 64) fwd_kernel(Args A) {
    extern __shared__ __attribute__((aligned(16))) unsigned char lds_raw[];
    LAS unsigned char* lds = (LAS unsigned char*)lds_raw;
    cg::grid_group grid = cg::this_grid();
    const int wave = __builtin_amdgcn_readfirstlane((int)threadIdx.x >> 6);
    const int lane = (int)__builtin_amdgcn_mbcnt_hi(~0u, __builtin_amdgcn_mbcnt_lo(~0u, 0u)), tid = wave * 64 + lane;
    const int G = gridDim.x, bx = blockIdx.x; const int vcu = (G % 8 == 0) ? (bx % 8) * (G / 8) + bx / 8 : bx;
    unsigned char* ws = A.ws;
    const int lo = A.ph_lo, hi = A.ph_hi;
#define IN(k) (lo <= (k) && (k) < hi)
#ifndef PROBE_MASK
#define PROBE_MASK 0
#endif
#define REPS(k) for (int rep_ = 0; rep_ < (((PROBE_MASK >> (k)) & 1) ? 2 : 1); ++rep_)
    volatile LAS unsigned* bst = (volatile LAS unsigned*)(lds + LDS_BYTES - 64);
    if (tid < 2) bst[tid] = 0u;
    __syncthreads();
    XcdBarrier bar; bar.bar = (unsigned*)(ws + WS_BAR); bar.x = 0; bar.st = bst;
    const bool t0 = (tid == 0);
    if (hi - lo > 1) bar = xcd_barrier_post((unsigned*)(ws + WS_BAR), bst, t0);
#define SEAM(k) do { if (IN(k) && IN((k) + 1)) { if ((k) == 0) grid.sync(); else xcd_barrier(bar, t0); } } while (0)
    bf16* XN = (bf16*)(ws + WS_XN);

    if (IN(0)) REPS(0) {
        LAS float* scr = (LAS float*)(lds + wave * 16384);
        const int gw = vcu * NWAVES + wave, NGW = G * NWAVES;
        const int ng1 = (G >= 64) ? NG1 : 0, nd8 = (G >= 64) ? ND8 : 0, nu3 = (G >= 64) ? NU3 : 0, wo0 = (G >= 64) ? 0 : I_O;
        {
            int base = 0;
#define P0_STREAM(W_, K_, N_, WT_, MODE_, FIRST_, CNT_) do { const int b_ = ((gw - base) % NGW + NGW) % NGW; \
                conv_stream(W_, K_, N_, WT_, MODE_, scr, (FIRST_) + b_, (FIRST_) + (CNT_), NGW, lane); base += (CNT_); } while (0)
            P0_STREAM(A.in[5], 768, 3072, (bf16*)(ws + WS_WUQ), 0, 0, I_UQ);
            P0_STREAM(A.in[6], 512, 4096, (bf16*)(ws + WS_WUKV), 0, 0, I_UKV);
            P0_STREAM(A.in[16], DM, DM, (bf16*)(ws + WS_WO), 0, 0, wo0);
            P0_STREAM(A.in[18], DM, DFF, (bf16*)(ws + WS_WGU), 1, ng1, I_G - ng1);
            P0_STREAM(A.in[19], DM, DFF, (bf16*)(ws + WS_WGU), 2, nu3, I_G - nu3);
            P0_STREAM(A.in[20], DFF, DM, (bf16*)(ws + WS_WDN), 0, nd8, I_D - nd8);
            P0_STREAM(A.in[2], DM, DIN, (bf16*)(ws + WS_WIN), 0, 0, I_IN);
#undef P0_STREAM
        }
        { u32x4* pz = (u32x4*)(ws + WS_WIN + (size_t)DIN * DM * 2); const int n16 = (ZLD - DIN) * DM * 2 / 16; const u32x4 z4 = {0u, 0u, 0u, 0u};
            for (int i = vcu * 512 + tid; i < n16; i += G * 512) pz[i] = z4; }
        for (int mrow = gw; mrow < SEQ; mrow += NGW) rms_row_4096(A.in[0] + (size_t)mrow * DM, A.in[1], XN + (size_t)mrow * DM, lane);
    }
    SEAM(0);
    if (IN(1)) REPS(1) {
        const int spare = (G >= 64) ? SPARE1 : 0, Gg = G - spare;
        if (bx < Gg) {
            pg8::Gemm g{XN, (const bf16*)(ws + WS_WIN), SEQ, ZLD, DM}; pg8::StaticOrder S; S.init(SEQ, ZLD, Gg, bx);
            pg8::EpiBf16S E{(bf16*)(ws + WS_Z), ZLD};
            pg8::gemm_phase<pg8::EpiBf16S, pg8::StaticOrder, true, true>(lds, g, S, E, tid);
        } else {
            LAS float* scr = (LAS float*)(lds + wave * 16384);
            const int sw = (bx - Gg) * NWAVES + wave, ns = spare * NWAVES;
            conv_stream(A.in[16], DM, DM, (bf16*)(ws + WS_WO), 0, scr, sw, I_O, ns, lane);
            conv_stream(A.in[18], DM, DFF, (bf16*)(ws + WS_WGU), 1, scr, sw, NG1, ns, lane);
        }
    }
    SEAM(1);
    if (IN(2)) REPS(2) p2_phase(A, lds, vcu, G, tid, wave, lane);
    SEAM(2);
    if (IN(3)) REPS(3) {
        { pg8::Gemm g{(const bf16*)(ws + WS_CQN), (const bf16*)(ws + WS_WUQ), SEQ, 3072, 768}; pg8::StaticOrder S; S.init(SEQ, 3072, G, G - 1 - bx);
          pg8::EpiBf16S E{(bf16*)(ws + WS_QRAW), 3072};
          pg8::gemm_phase<pg8::EpiBf16S, pg8::StaticOrder, true, true>(lds, g, S, E, tid); }
        { pg8::Gemm g{(const bf16*)(ws + WS_CKVN), (const bf16*)(ws + WS_WUKV), SEQ, 4096, 512}; pg8::StaticOrder S; S.init(SEQ, 4096, G, bx);
          pg8::EpiBf16S E{(bf16*)(ws + WS_KVRAW), 4096};
          pg8::gemm_phase<pg8::EpiBf16S, pg8::StaticOrder, true, true>(lds, g, S, E, tid); }
        if (G >= 64 && bx < G / 2)
            conv_stream(A.in[19], DM, DFF, (bf16*)(ws + WS_WGU), 2, (LAS float*)(lds + wave * 16384), bx * NWAVES + wave, NU3, (G / 2) * NWAVES, lane);
    }
    SEAM(3);
    if (IN(4)) REPS(4) p4_phase(A, lds, vcu, G, tid, wave, lane);
    SEAM(4);
    if (IN(5)) {
        float lam;
        { const float* q1 = A.in[11]; const float* k1 = A.in[12]; const float* q2 = A.in[13]; const float* k2 = A.in[14];
          const float s1 = wave_sum(q1[lane] * k1[lane] + q1[lane + 64] * k1[lane + 64]), s2 = wave_sum(q2[lane] * k2[lane] + q2[lane + 64] * k2[lane + 64]);
          lam = __uint_as_float(__builtin_amdgcn_readfirstlane(__float_as_uint(expf(s1) - expf(s2) + LAMBDA_INIT))); }
        const bf16* QA = (const bf16*)(ws + WS_QA); const bf16* KA = (const bf16*)(ws + WS_KA); const bf16* VAT = (const bf16*)(ws + WS_VAT);
        const bf16* QD = (const bf16*)(ws + WS_QD); const bf16* KD = (const bf16*)(ws + WS_KD); const bf16* VDT = (const bf16*)(ws + WS_VDT);
        bf16* OC = (bf16*)(ws + WS_OC);
        REPS(5) for (int p = vcu; p < 256; p += G) {
            { const int h = p >> 5, s = p & 31; att::diff_unit(h, 63 - s, lam, QD, KD, VDT, A.in[15], OC, lds, wave, lane); att::diff_unit(h, s, lam, QD, KD, VDT, A.in[15], OC, lds, wave, lane); }
            { const int h = p >> 4, s = p & 15; att::mla_unit(h, 31 - s, QA, KA, VAT, OC, lds, wave, lane); att::mla_unit(h, s, QA, KA, VAT, OC, lds, wave, lane); }
        }
    }
    SEAM(5);
    if (IN(6)) REPS(6) {
        pg8::Gemm g{(const bf16*)(ws + WS_OC), (const bf16*)(ws + WS_WO), SEQ, DM, DM}; pg8::StaticOrder S; S.init(SEQ, DM, G, bx);
        pg8::EpiResF32 E{A.in[0], A.out, DM};
        pg8::gemm_phase<pg8::EpiResF32, pg8::StaticOrder, true, true>(lds, g, S, E, wave * 64 + fresh_lane());
    }
    SEAM(6);
    if (IN(7)) REPS(7) {
        const int gw = vcu * NWAVES + wave, NGW = G * NWAVES;
        for (int mrow = gw; mrow < SEQ; mrow += NGW) rms_row_4096(A.out + (size_t)mrow * DM, A.in[17], XN + (size_t)mrow * DM, fresh_lane());
    }
    SEAM(7);
    if (IN(8)) REPS(8) {
        const int spare = (G >= 64) ? SPARE8 : 0, Gg = G - spare;
        if (bx < Gg) {
            pg8::Gemm g{XN, (const bf16*)(ws + WS_WGU), SEQ, 2 * DFF, DM}; pg8::StaticOrder S; S.init(SEQ, 2 * DFF, Gg, bx);
            pg8::EpiSwiGLU E{(bf16*)(ws + WS_ACT), DFF};
            pg8::gemm_phase<pg8::EpiSwiGLU, pg8::StaticOrder, true, true>(lds, g, S, E, wave * 64 + fresh_lane());
        } else {
            LAS float* scr = (LAS float*)(lds + wave * 16384);
            conv_stream(A.in[20], DFF, DM, (bf16*)(ws + WS_WDN), 0, scr, (bx - Gg) * NWAVES + wave, ND8, spare * NWAVES, fresh_lane());
        }
    }
    SEAM(8);
    if (IN(9)) REPS(9) {
        pg8::Gemm g{(const bf16*)(ws + WS_ACT), (const bf16*)(ws + WS_WDN), SEQ, DM, DFF}; pg8::StaticOrder S; S.init(SEQ, DM, G, bx);
        pg8::EpiResF32 E{A.out, A.out, DM};
        pg8::gemm_phase<pg8::EpiResF32, pg8::StaticOrder, true, true>(lds, g, S, E, wave * 64 + fresh_lane());
    }
#undef IN
#undef SEAM
}

#ifndef MK_PER_PHASE
#define MK_PER_PHASE 0
#endif
constexpr int N_PHASES = 10;
extern "C" void kernel_launch(void* const* d_in, const int* in_sizes, int n_in, void* d_out, int out_size, void* d_ws, size_t ws_size, hipStream_t stream) {
    static int grid = 0;
    if (grid == 0) {
        if (n_in != 21 || in_sizes[0] != SEQ * DM || out_size != SEQ * DM || ws_size < WS_END) { fprintf(stderr, "kernel_launch: unexpected shapes / workspace (n_in %d, ws %zu, need %zu)\n", n_in, ws_size, (size_t)WS_END); grid = -1; return; }
        int dev = 0, cus = 0, per_cu = 0;
        if (hipGetDevice(&dev) != hipSuccess || hipDeviceGetAttribute(&cus, hipDeviceAttributeMultiprocessorCount, dev) != hipSuccess) { grid = -1; return; }
        if (hipFuncSetAttribute((const void*)fwd_kernel, hipFuncAttributeMaxDynamicSharedMemorySize, LDS_BYTES) != hipSuccess) { fprintf(stderr, "kernel_launch: hipFuncSetAttribute failed\n"); grid = -1; return; }
        if (hipOccupancyMaxActiveBlocksPerMultiprocessor(&per_cu, (const void*)fwd_kernel, NWAVES * 64, LDS_BYTES) != hipSuccess || per_cu < 1) { fprintf(stderr, "kernel_launch: occupancy query gave %d\n", per_cu); per_cu = 1; }
        (void)hipGetLastError();
        grid = cus * per_cu;
    }
    if (grid < 0) return;
    if (hipMemsetAsync((char*)d_ws + WS_BAR, 0, XCD_BAR_WORDS * 4, stream) != hipSuccess) { fprintf(stderr, "kernel_launch: hipMemsetAsync failed\n"); return; }
    Args a{};
    for (int i = 0; i < 21; ++i) a.in[i] = (const float*)d_in[i];
    a.out = (float*)d_out; a.ws = (unsigned char*)d_ws;
    for (int j = 0; j < 64; ++j) a.invf[j] = (float)std::pow(10000.0, -(double)j / 64.0);
#if MK_PER_PHASE
#ifndef HOST_REP_MASK
#define HOST_REP_MASK 0
#endif
    for (int ph = 0; ph < N_PHASES; ++ph) for (int rep = 0; rep < (((HOST_REP_MASK >> ph) & 1) ? 2 : 1); ++rep) { a.ph_lo = ph; a.ph_hi = ph + 1; hipLaunchKernelGGL(fwd_kernel, dim3(grid), dim3(NWAVES * 64), LDS_BYTES, stream, a); }
#else
    a.ph_lo = 0; a.ph_hi = N_PHASES;
    void* args[] = {&a};
    hipError_t e = hipLaunchCooperativeKernel((const void*)fwd_kernel, dim3(grid), dim3(NWAVES * 64), args, LDS_BYTES, stream);
    if (e != hipSuccess) fprintf(stderr, "kernel_launch: cooperative launch failed: %s (grid %d)\n", hipGetErrorString(e), grid);
#endif
}
```
